# Optimizing an MI355X kernel written in HIP

```python
import math
import jax
import jax.numpy as jnp
from jax import lax
import numpy as np

D_MODEL = 2048
BATCH = 2
SEQ = 4096
DEPTH = 4

HEAD_DIM = 128
N_DIFF_HEADS = D_MODEL // (2 * HEAD_DIM)
DIFF_QK_DIM = HEAD_DIM // 2
N_NSA_HEADS = D_MODEL // (2 * HEAD_DIM)
N_NSA_KV = 2
NSA_HPG = N_NSA_HEADS // N_NSA_KV
NSA_CMP_LEN = 32
NSA_CMP_STRIDE = 16
NSA_CMP_HIDDEN = 256
NSA_SEL_BLOCK = 64
NSA_TOP_N = 16
NSA_WINDOW = 512
D_FF = 5632
ROPE_THETA = 500000.0
ROPE_FRACTION = 4
Q_BLOCK = 128
SEL_Q_BLOCK = 64
N_MOD = 9
RMS_EPS = 1e-6
NEG = -1e30
FORCE_BONUS = 1e6
DIFF_W = N_DIFF_HEADS * HEAD_DIM
NSA_W = N_NSA_HEADS * HEAD_DIM
NSA_KV_W = N_NSA_KV * HEAD_DIM
IN_COLS = 3 * DIFF_W + NSA_W + 6 * NSA_KV_W + 3 * N_NSA_HEADS

kernel_name = 'hybrid_diffattn_nsa_macaron_adaln'


def rms_norm(x, g):
    xf = x.astype(jnp.float32)
    y = xf * lax.rsqrt(jnp.mean(xf * xf, axis=-1, keepdims=True) + RMS_EPS)
    return (y * g.astype(jnp.float32)).astype(x.dtype)


def rope(x, rot_dim):
    S = x.shape[1]
    half = rot_dim // 2
    inv = jnp.exp(-math.log(ROPE_THETA) * jnp.arange(half, dtype=jnp.float32) / half)
    ang = jnp.arange(S, dtype=jnp.float32)[:, None] * inv[None, :]
    shp = (S,) + (1,) * (x.ndim - 3) + (half,)
    cos = jnp.cos(ang).reshape(shp).astype(x.dtype)
    sin = jnp.sin(ang).reshape(shp).astype(x.dtype)
    x1 = x[..., :half]
    x2 = x[..., half:rot_dim]
    return jnp.concatenate([x1 * cos - x2 * sin, x2 * cos + x1 * sin, x[..., rot_dim:]], axis=-1)


def swiglu(h, w_gu, w_d):
    g, u = jnp.split(h @ w_gu, 2, axis=-1)
    return (jax.nn.silu(g) * u) @ w_d


def gather_rows(a, idx):
    return jax.vmap(jax.vmap(lambda ai, ii: ai[ii]))(a, idx)


def diff_attention(q, k, v, lam, subln_g, lam_init):
    B, S, H = q.shape[0], q.shape[1], q.shape[2]
    nb = S // Q_BLOCK
    scale = DIFF_QK_DIM ** -0.5
    kpos = jnp.arange(S)
    vf = v.astype(jnp.float32)

    def block(i):
        t0 = i * Q_BLOCK
        qb = lax.dynamic_slice_in_dim(q, t0, Q_BLOCK, axis=1)
        s = jnp.einsum('bqhcd,bkhcd->bhcqk', qb, k).astype(jnp.float32) * scale
        mask = (t0 + jnp.arange(Q_BLOCK))[:, None] >= kpos[None, :]
        p = jax.nn.softmax(jnp.where(mask, s, NEG), axis=-1)
        a = p[:, :, 0] - lam * p[:, :, 1]
        return jnp.einsum('bhqk,bkhd->bqhd', a, vf)

    o = lax.map(block, jnp.arange(nb))
    o = o.transpose(1, 0, 2, 3, 4).reshape(B, S, H, HEAD_DIM)
    o = rms_norm(o, subln_g) * (1.0 - lam_init)
    return o.astype(v.dtype)


def nsa_attention(q, k_c, v_c, k_s, v_s, k_w, v_w, gates, cmp_pe, cmp_w1, cmp_w2):
    B, S, H, dk = q.shape
    G, J = N_NSA_KV, NSA_HPG
    qg = q.reshape(B, S, G, J, dk)
    scale = dk ** -0.5
    tpos = jnp.arange(S)

    nc = (S - NSA_CMP_LEN) // NSA_CMP_STRIDE + 1
    cidx = jnp.arange(nc)[:, None] * NSA_CMP_STRIDE + jnp.arange(NSA_CMP_LEN)[None, :]

    def compress(kv, j):
        blk = kv[:, cidx] + cmp_pe[j][None, None, :, None, :]
        blk = blk.transpose(0, 1, 3, 2, 4).reshape(B, nc, G, NSA_CMP_LEN * dk)
        return jax.nn.silu(blk @ cmp_w1[j]) @ cmp_w2[j]

    kc = compress(k_c, 0)
    vc = compress(v_c, 1)
    s_c = jnp.einsum('bsgjd,bngd->bgjsn', qg, kc).astype(jnp.float32) * scale
    cend = jnp.arange(nc) * NSA_CMP_STRIDE + NSA_CMP_LEN - 1
    cmask = cend[None, :] <= tpos[:, None]
    p_c = jnp.where(cmask, jax.nn.softmax(jnp.where(cmask, s_c, NEG), axis=-1), 0.0)
    o_c = jnp.einsum('bgjsn,bngd->bsgjd', p_c, vc.astype(jnp.float32))

    ns = S // NSA_SEL_BLOCK
    n_top = min(NSA_TOP_N, ns)
    cs = jnp.arange(nc) * NSA_CMP_STRIDE
    ss = jnp.arange(ns) * NSA_SEL_BLOCK
    ov = jnp.clip(jnp.minimum(cs[:, None] + NSA_CMP_LEN, ss[None, :] + NSA_SEL_BLOCK)
                  - jnp.maximum(cs[:, None], ss[None, :]), 0, None).astype(jnp.float32) / NSA_CMP_LEN
    imp = jnp.einsum('bgjsn,nm->bgsm', p_c, ov)
    sblk = jnp.arange(ns)[None, :]
    cur = (tpos // NSA_SEL_BLOCK)[:, None]
    valid = sblk * NSA_SEL_BLOCK <= tpos[:, None]
    forced = (sblk == 0) | (sblk == cur) | (sblk == cur - 1)
    score = jnp.where(valid, imp + jnp.where(forced, FORCE_BONUS, 0.0), NEG)
    top_val, top_idx = lax.top_k(score, n_top)
    top_ok = top_val > 0.5 * NEG

    kv_blk = jnp.concatenate([k_s, v_s], axis=-1).transpose(0, 2, 1, 3)
    kv_blk = kv_blk.reshape(B, G, ns, NSA_SEL_BLOCK, 2 * dk)

    def sel_block(i):
        t0 = i * SEL_Q_BLOCK
        qb = lax.dynamic_slice_in_dim(qg, t0, SEL_Q_BLOCK, axis=1)
        ib = lax.dynamic_slice_in_dim(top_idx, t0, SEL_Q_BLOCK, axis=2)
        okb = lax.dynamic_slice_in_dim(top_ok, t0, SEL_Q_BLOCK, axis=2)
        kvg = gather_rows(kv_blk, ib.reshape(B, G, SEL_Q_BLOCK * n_top))
        kvg = kvg.reshape(B, G, SEL_Q_BLOCK, n_top * NSA_SEL_BLOCK, 2 * dk)
        kg = kvg[..., :dk]
        vg = kvg[..., dk:].astype(jnp.float32)
        s = jnp.einsum('bqgjd,bgqkd->bgjqk', qb, kg).astype(jnp.float32) * scale
        tok = (ib[..., None] * NSA_SEL_BLOCK + jnp.arange(NSA_SEL_BLOCK)).reshape(B, G, SEL_Q_BLOCK, -1)
        tq = t0 + jnp.arange(SEL_Q_BLOCK)
        m = (tok <= tq[:, None]) & jnp.repeat(okb, NSA_SEL_BLOCK, axis=-1)
        p = jax.nn.softmax(jnp.where(m[:, :, None], s, NEG), axis=-1)
        return jnp.einsum('bgjqk,bgqkd->bqgjd', p, vg)

    o_s = lax.map(sel_block, jnp.arange(S // SEL_Q_BLOCK))
    o_s = o_s.transpose(1, 0, 2, 3, 4, 5).reshape(B, S, G, J, dk)

    nb = S // Q_BLOCK
    span = NSA_WINDOW + Q_BLOCK
    widx = jnp.arange(nb)[:, None] * Q_BLOCK + jnp.arange(span)[None, :]
    pad = ((0, 0), (NSA_WINDOW, 0), (0, 0), (0, 0))
    kb = jnp.pad(k_w, pad)[:, widx]
    vb = jnp.pad(v_w, pad)[:, widx].astype(jnp.float32)
    qb = qg.reshape(B, nb, Q_BLOCK, G, J, dk)
    s_w = jnp.einsum('bnqgjd,bnkgd->bngjqk', qb, kb).astype(jnp.float32) * scale
    kpos = widx - NSA_WINDOW
    qpos = jnp.arange(nb)[:, None] * Q_BLOCK + jnp.arange(Q_BLOCK)[None, :]
    dist = qpos[:, :, None] - kpos[:, None, :]
    wmask = (dist >= 0) & (dist < NSA_WINDOW) & (kpos[:, None, :] >= 0)
    p_w = jax.nn.softmax(jnp.where(wmask[None, :, None, None], s_w, NEG), axis=-1)
    o_w = jnp.einsum('bngjqk,bnkgd->bnqgjd', p_w, vb).reshape(B, S, G, J, dk)

    g = gates.reshape(B, S, G, J, 3)
    o = g[..., 0:1] * o_c + g[..., 1:2] * o_s + g[..., 2:3] * o_w
    return o.reshape(B, S, H * dk)


def token_mixer(h, w_in, w_o, diff_lam, diff_subln, cmp_pe, cmp_w1, cmp_w2, lam_init):
    B, S, _ = h.shape
    proj = h @ w_in
    sizes = [DIFF_W, DIFF_W, DIFF_W, NSA_W] + [NSA_KV_W] * 6 + [3 * N_NSA_HEADS]
    offs = []
    acc = 0
    for sz in sizes[:-1]:
        acc += sz
        offs.append(acc)
    dq, dk_, dv, nq, kc, vc, ks, vs, kw, vw, gl = jnp.split(proj, offs, axis=-1)

    dq = rope(dq.reshape(B, S, N_DIFF_HEADS, 2, DIFF_QK_DIM), DIFF_QK_DIM // ROPE_FRACTION)
    dk_ = rope(dk_.reshape(B, S, N_DIFF_HEADS, 2, DIFF_QK_DIM), DIFF_QK_DIM // ROPE_FRACTION)
    dv = dv.reshape(B, S, N_DIFF_HEADS, HEAD_DIM)
    lf = diff_lam.astype(jnp.float32)
    lam = jnp.exp(jnp.sum(lf[0] * lf[1])) - jnp.exp(jnp.sum(lf[2] * lf[3])) + lam_init
    o_diff = diff_attention(dq, dk_, dv, lam, diff_subln, lam_init)

    kvs = (B, S, N_NSA_KV, HEAD_DIM)
    rot = HEAD_DIM // ROPE_FRACTION
    nq = rope(nq.reshape(B, S, N_NSA_HEADS, HEAD_DIM), rot)
    ks = rope(ks.reshape(kvs), rot)
    kw = rope(kw.reshape(kvs), rot)
    gates = jax.nn.sigmoid(gl.reshape(B, S, N_NSA_HEADS, 3))
    o_nsa = nsa_attention(nq, kc.reshape(kvs), vc.reshape(kvs), ks, vs.reshape(kvs),
                          kw, vw.reshape(kvs), gates, cmp_pe, cmp_w1, cmp_w2)

    o = jnp.concatenate([o_diff.reshape(B, S, DIFF_W), o_nsa.astype(h.dtype)], axis=-1)
    return o @ w_o


def setup_inputs(seed: int = 0) -> dict:
    key = jax.random.key(seed)
    ks = jax.random.split(key, 15)
    f32 = jnp.float32
    D = D_MODEL
    cl_dk = NSA_CMP_LEN * HEAD_DIM
    return {
        'x': jax.random.normal(ks[0], (BATCH, SEQ, D), f32),
        'c': jax.random.normal(ks[1], (BATCH, D), f32),
        'w_ada': jax.random.normal(ks[2], (DEPTH, D, N_MOD * D), f32) * (0.5 * D ** -0.5),
        'b_ada': jax.random.normal(ks[3], (DEPTH, N_MOD * D), f32) * 0.02,
        'norm_g': 1.0 + 0.02 * jax.random.normal(ks[4], (DEPTH, 3, D), f32),
        'ffn_w_gu': jax.random.normal(ks[5], (DEPTH, 2, D, 2 * D_FF), f32) * D ** -0.5,
        'ffn_w_d': jax.random.normal(ks[6], (DEPTH, 2, D_FF, D), f32) * D_FF ** -0.5,
        'w_in': jax.random.normal(ks[7], (DEPTH, D, IN_COLS), f32) * D ** -0.5,
        'w_o': jax.random.normal(ks[8], (DEPTH, D, D), f32) * D ** -0.5,
        'diff_lam': jax.random.normal(ks[9], (DEPTH, 4, DIFF_QK_DIM), f32) * 0.1,
        'diff_subln': 1.0 + 0.02 * jax.random.normal(ks[10], (DEPTH, HEAD_DIM), f32),
        'cmp_pe': jax.random.normal(ks[11], (DEPTH, 2, NSA_CMP_LEN, HEAD_DIM), f32) * 0.1,
        'cmp_w1': jax.random.normal(ks[12], (DEPTH, 2, cl_dk, NSA_CMP_HIDDEN), f32) * cl_dk ** -0.5,
        'cmp_w2': jax.random.normal(ks[13], (DEPTH, 2, NSA_CMP_HIDDEN, HEAD_DIM), f32) * NSA_CMP_HIDDEN ** -0.5,
        'final_g': 1.0 + 0.02 * jax.random.normal(ks[14], (D,), f32),
    }


def reference(x, c, w_ada, b_ada, norm_g, ffn_w_gu, ffn_w_d, w_in, w_o, diff_lam,
              diff_subln, cmp_pe, cmp_w1, cmp_w2, final_g):
    B = x.shape[0]
    D = x.shape[-1]
    cs = jax.nn.silu(c)
    for l in range(DEPTH):
        mod = (cs @ w_ada[l] + b_ada[l]).reshape(B, N_MOD, 1, D)
        lam_init = 0.8 - 0.6 * math.exp(-0.3 * l)
        h = rms_norm(x, norm_g[l, 0]) * (1.0 + mod[:, 1]) + mod[:, 0]
        x = x + 0.5 * mod[:, 2] * swiglu(h, ffn_w_gu[l, 0], ffn_w_d[l, 0])
        h = rms_norm(x, norm_g[l, 1]) * (1.0 + mod[:, 4]) + mod[:, 3]
        x = x + mod[:, 5] * token_mixer(h, w_in[l], w_o[l], diff_lam[l], diff_subln[l],
                                        cmp_pe[l], cmp_w1[l], cmp_w2[l], lam_init)
        h = rms_norm(x, norm_g[l, 2]) * (1.0 + mod[:, 7]) + mod[:, 6]
        x = x + 0.5 * mod[:, 8] * swiglu(h, ffn_w_gu[l, 1], ffn_w_d[l, 1])
    return rms_norm(x, final_g)
```

```cpp
#include <hip/hip_runtime.h>
#include <hip/hip_bf16.h>
#include <cstdio>
#include <cstdint>
namespace pg8 {
#define PG8_LAS __attribute__((address_space(3)))
typedef unsigned short bf16_t;
typedef short bf16x8 __attribute__((ext_vector_type(8)));
typedef float f32x4 __attribute__((ext_vector_type(4)));
typedef unsigned u32x4 __attribute__((ext_vector_type(4)));
constexpr int BM = 256, BK = 64, HALF = 128, HTB = HALF * BK * 2  , STAGE_BYTES = 8 * HTB, NXCD = 8, WGM = 8;

__host__ __device__ __forceinline__ int lds_byte(int r, int c) { const int st = (r >> 4) * 2 + (c >> 5), rr = r & 15, cc = c & 31, ob = rr * 64 + cc * 2; return st * 1024 + (ob ^ (((ob >> 9) & 1) << 5)); }
__host__ __device__ __forceinline__ void stage_rc(int b, int& R, int& C) { const int st = b / 1024, sb = b % 1024, swz = sb ^ (((sb >> 9) & 1) << 5); R = (st >> 1) * 16 + swz / 64; C = (st & 1) * 32 + (swz % 64) / 2; }
__host__ __device__ __forceinline__ int perm32(int rho) { const int n = rho >> 4, i = rho & 15; return 8 * (i >> 2) + 4 * n + (i & 3); }

struct Unit { int pm, pn; };
struct Gemm { const bf16_t* A; const bf16_t* Bt; int M, N, K; };

struct StaticOrder {
    int nM, nN, nwg, G, c;
    __host__ __device__ void init(int M, int N, int G_, int c_) { nM = M / BM; nN = N / BM; nwg = nM * nN; G = G_; c = c_; }
    __host__ __device__ bool next(int i, Unit& u) const {
        const long L = (long)i * G + c; if (L >= nwg) return false;
        int wgid = (int)L; { const int q = nwg / NXCD, r = nwg % NXCD, xcd = wgid % NXCD, off = wgid / NXCD; wgid = (xcd < r ? xcd * (q + 1) : r * (q + 1) + (xcd - r) * q) + off; }
        const int nig = WGM * nN, gid = wgid / nig, fm = gid * WGM, gsz = (nM - fm) < WGM ? (nM - fm) : WGM;
        u.pm = fm + ((wgid % nig) % gsz); u.pn = (wgid % nig) / gsz; return true;
    }
    __device__ __forceinline__ void a_ready(const Unit&) const {}
    __device__ __forceinline__ void done(const Unit&) const {}
};

__device__ __forceinline__ unsigned cvt_pk_bf16(float lo, float hi) { unsigned r; asm volatile("v_cvt_pk_bf16_f32 %0, %1, %2" : "=v"(r) : "v"(lo), "v"(hi)); return r; }
typedef float f32x2 __attribute__((ext_vector_type(2)));
typedef float f32x2_t __attribute__((ext_vector_type(2))); typedef __bf16 bf16x2_t __attribute__((ext_vector_type(2)));
__device__ __forceinline__ unsigned cvtpk(float lo, float hi) { f32x2_t v = {lo, hi}; bf16x2_t b = __builtin_convertvector(v, bf16x2_t); return __builtin_bit_cast(unsigned, b); }
__host__ __device__ __forceinline__ int swap23(int r) { return (r & ~12) | ((r & 4) << 1) | ((r & 8) >> 1); }
__device__ __forceinline__ float silu_f(float g) { return g * __builtin_amdgcn_rcpf(1.0f + __builtin_amdgcn_exp2f(-1.4426950408889634f * g)); }
__device__ __forceinline__ float sigmoid_f(float g) { return __builtin_amdgcn_rcpf(1.0f + __builtin_amdgcn_exp2f(-1.4426950408889634f * g)); }

struct EpiSwiglu {
    static constexpr bool PERM = true, AFTER_DRAIN = false;
    bf16_t* act; int ldc;
    __device__ __forceinline__ void operator()(const f32x4 (&acc)[2][2][4][2], const Unit& u, int wr, int wc, int fr, int fq) const {
        const int row0 = u.pm * BM + wr * 64 + fr, col0 = u.pn * 128 + wc * 32 + 8 * fq;
#pragma unroll
        for (int ai = 0; ai < 2; ++ai)
#pragma unroll
            for (int m = 0; m < 4; ++m) {
                bf16_t* rowp = act + (size_t)(row0 + ai * HALF + m * 16) * ldc + col0;
                const f32x4 g0 = acc[ai][0][m][0], g1 = acc[ai][0][m][1], u0 = acc[ai][1][m][0], u1 = acc[ai][1][m][1];
                u32x4 w;
                w.x = cvtpk(silu_f(g0[0]) * u0[0], silu_f(g0[1]) * u0[1]); w.y = cvtpk(silu_f(g0[2]) * u0[2], silu_f(g0[3]) * u0[3]);
                w.z = cvtpk(silu_f(g1[0]) * u1[0], silu_f(g1[1]) * u1[1]); w.w = cvtpk(silu_f(g1[2]) * u1[2], silu_f(g1[3]) * u1[3]);
                *(u32x4*)rowp = w;
            }
    }
};
struct EpiResid {
    static constexpr bool PERM = false, AFTER_DRAIN = false;
    float* x; const float* gate; int gstride; float coef;
    __device__ __forceinline__ void operator()(const f32x4 (&acc)[2][2][4][2], const Unit& u, int wr, int wc, int fr, int fq) const {
        const int row0 = u.pm * BM + wr * 64 + fr, col0 = u.pn * BM + wc * 32 + 4 * fq;
        const float* gp = gate + (size_t)(u.pm >> 4) * gstride;
#pragma unroll
        for (int bj = 0; bj < 2; ++bj)
#pragma unroll
            for (int n = 0; n < 2; ++n) {
                const int col = col0 + bj * HALF + n * 16;
                const f32x4 gv = *(const f32x4*)(gp + col) * coef;
#pragma unroll
                for (int ai = 0; ai < 2; ++ai)
#pragma unroll
                    for (int m = 0; m < 4; ++m) {
                        float* p = x + (size_t)(row0 + ai * HALF + m * 16) * 2048 + col;
                        const f32x4 xv = *(const f32x4*)p;
                        *(f32x4*)p = xv + gv * acc[ai][bj][m][n];
                    }
            }
    }
};
struct EpiVT {
    static constexpr bool PERM = true, AFTER_DRAIN = false;
    bf16_t* vtt;
    __device__ __forceinline__ void operator()(const f32x4 (&acc)[2][2][4][2], const Unit& u, int wr, int wc, int fr, int fq) const {
#pragma unroll
        for (int ai = 0; ai < 2; ++ai)
#pragma unroll
            for (int m = 0; m < 4; ++m) {
                const int row = u.pm * BM + ai * HALF + wr * 64 + m * 16 + fr, slot = row >> 7, dt = (row >> 5) & 3, d = row & 31;
#pragma unroll
                for (int bj = 0; bj < 2; ++bj) {
                    const int tc = 32 * u.pn + 16 * bj + 4 * wc + fq, T = tc >> 2, s = (tc >> 1) & 1, h2 = tc & 1;
                    const f32x4 v0 = acc[ai][bj][m][0], v1 = acc[ai][bj][m][1];
                    u32x4 w; w.x = cvtpk(v0[0], v0[1]); w.y = cvtpk(v0[2], v0[3]); w.z = cvtpk(v1[0], v1[1]); w.w = cvtpk(v1[2], v1[3]);
                    *(u32x4*)(vtt + ((size_t)((((slot * 4 + dt) * 256 + T) * 2 + s) * 64 + h2 * 32 + d)) * 8) = w;
                }
            }
    }
};
struct EpiNat {
    static constexpr bool PERM = true, AFTER_DRAIN = false;
    bf16_t* nat; float* gates; const float* rope; float qs_d, qs_n;
    __device__ __forceinline__ void operator()(const f32x4 (&acc)[2][2][4][2], const Unit& u, int wr, int wc, int fr, int fq) const {
        asm volatile("" : "+v"(fr), "+v"(fq));
#pragma unroll
        for (int bj = 0; bj < 2; ++bj) {
            const int slot = 2 * u.pn + bj;
            if (slot >= 33) continue;
            const bool r64 = slot < 16, r128 = (slot >= 16 && slot < 24) || (slot >= 28 && slot < 32);
            const bool ktype = (slot >= 8 && slot < 16) || (slot >= 28 && slot < 32);
            const float sc = slot < 8 ? qs_d : ((slot >= 16 && slot < 24) ? qs_n : 1.0f);
#pragma unroll
            for (int ai = 0; ai < 2; ++ai)
#pragma unroll
                for (int m = 0; m < 4; ++m) {
                    const int row = u.pm * BM + ai * HALF + wr * 64 + m * 16 + fr, b = row >> 12, t = row & 4095;
                    float v[8];
#pragma unroll
                    for (int e = 0; e < 4; ++e) { v[e] = acc[ai][bj][m][0][e]; v[4 + e] = acc[ai][bj][m][1][e]; }
                    if (slot == 32) {
                        if (wc == 0 && fq < 3) {
                            float* gp = gates + (size_t)row * 24 + 8 * fq;
                            *(f32x4*)gp = (f32x4){sigmoid_f(v[0]), sigmoid_f(v[1]), sigmoid_f(v[2]), sigmoid_f(v[3])};
                            *(f32x4*)(gp + 4) = (f32x4){sigmoid_f(v[4]), sigmoid_f(v[5]), sigmoid_f(v[6]), sigmoid_f(v[7])};
                        }
                        continue;
                    }
                    const float* rp = rope + (size_t)t * 48;
                    if (r64 && (wc & 1) == 0) {
                        const f32x4 c0 = *(const f32x4*)(rp), c1 = *(const f32x4*)(rp + 4), s0 = *(const f32x4*)(rp + 8), s1 = *(const f32x4*)(rp + 12);
#pragma unroll
                        for (int e = 0; e < 8; ++e) {
                            const float pv = __shfl_xor(v[e], 16), cs = e < 4 ? c0[e & 3] : c1[e & 3], sn = e < 4 ? s0[e & 3] : s1[e & 3];
                            const float rot = fq == 0 ? v[e] * cs - pv * sn : v[e] * cs + pv * sn;
                            v[e] = fq < 2 ? rot : v[e];
                        }
                    }
                    if (r128 && wc == 0) {
                        const float* cp = rp + 16 + 8 * (fq & 1); const float* sp = rp + 32 + 8 * (fq & 1);
                        const f32x4 c0 = *(const f32x4*)(cp), c1 = *(const f32x4*)(cp + 4), s0 = *(const f32x4*)(sp), s1 = *(const f32x4*)(sp + 4);
#pragma unroll
                        for (int e = 0; e < 8; ++e) {
                            const float pv = __shfl_xor(v[e], 32), cs = e < 4 ? c0[e & 3] : c1[e & 3], sn = e < 4 ? s0[e & 3] : s1[e & 3];
                            v[e] = fq < 2 ? v[e] * cs - pv * sn : v[e] * cs + pv * sn;
                        }
                    }
                    u32x4 w; w.x = cvtpk(v[0] * sc, v[1] * sc); w.y = cvtpk(v[2] * sc, v[3] * sc); w.z = cvtpk(v[4] * sc, v[5] * sc); w.w = cvtpk(v[6] * sc, v[7] * sc);
                    const int dc = 4 * wc + fq;
                    bf16_t* base = nat + (size_t)(slot * 2 + b) * (4096 * 128);
                    if (slot >= 24 && slot < 28) *(u32x4*)(base + (size_t)t * 128 + dc * 8) = w;
                    else { const int rp2 = ktype ? swap23(t & 31) : (t & 31);
                        *(u32x4*)(base + ((size_t)(((t >> 5) * 8 + (dc >> 1)) * 64 + (dc & 1) * 32 + rp2)) * 8) = w; }
                }
        }
    }
};
template <class Epi, class Sched, bool ALIGN_EPI = false, bool SP2 = false>
__device__ __forceinline__ void gemm_phase(PG8_LAS unsigned char* lds, const Gemm g, const Sched& S, const Epi& E) {
    int tid0_ = threadIdx.x; asm volatile("" : "+v"(tid0_));
    const int tid = tid0_, wid = __builtin_amdgcn_readfirstlane(tid >> 6), lane = tid & 63, wr = wid >> 2, wc = wid & 3, fr = lane & 15, fq = lane >> 4;
    const int K = g.K, nt = K / BK;
    unsigned voffA[2], voffB[2];
#pragma unroll
    for (int i = 0; i < 2; ++i) { int R, C; stage_rc(tid * 16 + i * 8192, R, C); const int Rb = Epi::PERM ? ((R & ~31) + perm32(R & 31)) : R;
        voffA[i] = (unsigned)(R * K + C) * 2u; voffB[i] = (unsigned)(Rb * K + C) * 2u; }
    const size_t kstep = (size_t)(BK * 2);
    const size_t hstep = (size_t)HALF * K * 2;
    const size_t tstep = 2 * hstep;
    const unsigned ldsw = (unsigned)wid * 1024u;
    const int aoff = lds_byte(wr * 64 + fr, fq * 8), boff = lds_byte(wc * 32 + fr, fq * 8);
#define PG8_SA(b, h) (((b) * 2 + (h)) * HTB)
#define PG8_SB(b, h) ((4 + (b) * 2 + (h)) * HTB)
#define PG8_STAGE(bufoff, gbase, voff) do { _Pragma("unroll") for (int _i = 0; _i < 2; ++_i) \
        __builtin_amdgcn_global_load_lds((const unsigned*)((const char*)(gbase) + (voff)[_i]), (PG8_LAS unsigned*)(lds + (bufoff) + ldsw + _i * 8192), 16, 0, 0); } while (0)
#define PG8_LDA(dst, b, h) do { _Pragma("unroll") for (int m = 0; m < 4; ++m) _Pragma("unroll") for (int k = 0; k < 2; ++k) dst[m][k] = *(const PG8_LAS bf16x8*)(lds + PG8_SA(b, h) + aoff + m * 2048 + k * 1024); } while (0)
#define PG8_LDB(dst, b, h) do { _Pragma("unroll") for (int n = 0; n < 2; ++n) _Pragma("unroll") for (int k = 0; k < 2; ++k) dst[n][k] = *(const PG8_LAS bf16x8*)(lds + PG8_SB(b, h) + boff + n * 2048 + k * 1024); } while (0)
#define PG8_MMA(ai, bj, At, Bt) do { __builtin_amdgcn_s_setprio(1); _Pragma("unroll") for (int m = 0; m < 4; ++m) _Pragma("unroll") for (int n = 0; n < 2; ++n) _Pragma("unroll") for (int k = 0; k < 2; ++k) \
        acc[ai][bj][m][n] = __builtin_amdgcn_mfma_f32_16x16x32_bf16(Bt[n][k], At[m][k], acc[ai][bj][m][n], 0, 0, 0); __builtin_amdgcn_s_setprio(0); } while (0)
#define PG8_WAIT_V(n) asm volatile("s_waitcnt vmcnt(" #n ")" ::: "memory")
#define PG8_WAIT_L(n) asm volatile("s_waitcnt lgkmcnt(" #n ")" ::: "memory")
#define PG8_BAR __builtin_amdgcn_s_barrier()
#define PG8_SCHED __builtin_amdgcn_sched_barrier(0)
    Unit cur, nxt; int ui = 0;
    if (!S.next(0, cur)) return;
    f32x4 acc[2][2][4][2];
#pragma unroll
    for (int a = 0; a < 2; ++a)
#pragma unroll
        for (int b = 0; b < 2; ++b)
#pragma unroll
            for (int m = 0; m < 4; ++m)
#pragma unroll
                for (int n = 0; n < 2; ++n) acc[a][b][m][n] = (f32x4){0.f, 0.f, 0.f, 0.f};
    bf16x8 At[4][2], B0[2][2], B1[2][2];
    const char* cA = (const char*)g.A + (size_t)cur.pm * tstep; const char* cB = (const char*)g.Bt + (size_t)cur.pn * tstep;
    S.a_ready(cur);
    if constexpr (SP2) {
        PG8_STAGE(PG8_SB(0, 0), cB, voffB); PG8_STAGE(PG8_SB(0, 1), cB + hstep, voffB); PG8_STAGE(PG8_SA(0, 0), cA, voffA); PG8_STAGE(PG8_SA(0, 1), cA + hstep, voffA);
        if (wr == 1) PG8_BAR;
        PG8_WAIT_V(2); PG8_BAR;
        PG8_STAGE(PG8_SB(1, 0), cB + kstep, voffB); PG8_STAGE(PG8_SA(1, 0), cA + kstep, voffA); PG8_STAGE(PG8_SB(1, 1), cB + hstep + kstep, voffB);
        PG8_WAIT_V(6); PG8_BAR;
    } else {
        PG8_STAGE(PG8_SB(0, 0), cB, voffB); PG8_STAGE(PG8_SA(0, 0), cA, voffA); PG8_STAGE(PG8_SB(0, 1), cB + hstep, voffB); PG8_STAGE(PG8_SA(0, 1), cA + hstep, voffA);
        if (wr == 1) PG8_BAR;
        PG8_WAIT_V(4); PG8_BAR;
        PG8_STAGE(PG8_SB(1, 0), cB + kstep, voffB); PG8_STAGE(PG8_SA(1, 0), cA + kstep, voffA); PG8_STAGE(PG8_SB(1, 1), cB + hstep + kstep, voffB);
        PG8_WAIT_V(6); PG8_BAR;
    }
    for (;;) {
        const bool has_next = S.next(ui + 1, nxt);
        const char* nA = has_next ? (const char*)g.A + (size_t)nxt.pm * tstep : cA; const char* nB = has_next ? (const char*)g.Bt + (size_t)nxt.pn * tstep : cB;
        for (int t = 0; t < nt; t += 2) {
            const bool last = (t == nt - 2);
            const char* a1 = cA + (size_t)(t + 1) * kstep;
            const char* a2 = last ? nA : cA + (size_t)(t + 2) * kstep; const char* b2 = last ? nB : cB + (size_t)(t + 2) * kstep;
            const char* a3 = a2 + kstep; const char* b3 = b2 + kstep;
            if (last && has_next) S.a_ready(nxt);
            if constexpr (SP2) {
            PG8_LDB(B0, 0, 0); PG8_LDB(B1, 0, 1); PG8_SCHED; PG8_LDA(At, 0, 0); PG8_STAGE(PG8_SA(1, 1), a1 + hstep, voffA);
            PG8_WAIT_V(8); PG8_WAIT_L(0); PG8_BAR; PG8_MMA(0, 0, At, B0); PG8_MMA(0, 1, At, B1); PG8_BAR; PG8_SCHED;
            PG8_LDA(At, 0, 1); PG8_STAGE(PG8_SB(0, 0), b2, voffB); PG8_STAGE(PG8_SB(0, 1), b2 + hstep, voffB); PG8_STAGE(PG8_SA(0, 0), a2, voffA);
            PG8_WAIT_V(8); PG8_WAIT_L(0); PG8_BAR; PG8_MMA(1, 0, At, B0); PG8_MMA(1, 1, At, B1); PG8_BAR; PG8_SCHED;
            PG8_LDB(B0, 1, 0); PG8_LDB(B1, 1, 1); PG8_SCHED; PG8_LDA(At, 1, 0); PG8_STAGE(PG8_SA(0, 1), a2 + hstep, voffA);
            PG8_WAIT_V(8); PG8_WAIT_L(0); PG8_BAR; PG8_MMA(0, 0, At, B0); PG8_MMA(0, 1, At, B1); PG8_BAR; PG8_SCHED;
            PG8_LDA(At, 1, 1); PG8_STAGE(PG8_SB(1, 0), b3, voffB); PG8_STAGE(PG8_SB(1, 1), b3 + hstep, voffB); PG8_STAGE(PG8_SA(1, 0), a3, voffA);
            PG8_WAIT_V(8); PG8_WAIT_L(0); PG8_BAR; PG8_MMA(1, 0, At, B0); PG8_MMA(1, 1, At, B1); PG8_BAR; PG8_SCHED;
            } else {
            PG8_LDB(B0, 0, 0); PG8_SCHED; PG8_LDA(At, 0, 0); PG8_STAGE(PG8_SA(1, 1), a1 + hstep, voffA);
            PG8_WAIT_L(8); PG8_BAR; PG8_WAIT_L(0); PG8_MMA(0, 0, At, B0); PG8_BAR; PG8_SCHED;
            PG8_LDB(B1, 0, 1); PG8_STAGE(PG8_SB(0, 0), b2, voffB);
            PG8_BAR; PG8_WAIT_L(0); PG8_MMA(0, 1, At, B1); PG8_BAR;
            PG8_LDA(At, 0, 1); PG8_STAGE(PG8_SA(0, 0), a2, voffA);
            PG8_BAR; PG8_WAIT_L(0); PG8_MMA(1, 0, At, B0); PG8_BAR; PG8_SCHED;
            PG8_STAGE(PG8_SB(0, 1), b2 + hstep, voffB);
            PG8_WAIT_V(6); PG8_BAR; PG8_MMA(1, 1, At, B1); PG8_BAR;
            PG8_LDB(B0, 1, 0); PG8_SCHED; PG8_LDA(At, 1, 0); PG8_STAGE(PG8_SA(0, 1), a2 + hstep, voffA);
            PG8_WAIT_L(8); PG8_BAR; PG8_WAIT_L(0); PG8_MMA(0, 0, At, B0); PG8_BAR; PG8_SCHED;
            PG8_LDB(B1, 1, 1); PG8_STAGE(PG8_SB(1, 0), b3, voffB);
            PG8_BAR; PG8_WAIT_L(0); PG8_MMA(0, 1, At, B1); PG8_BAR;
            PG8_LDA(At, 1, 1); PG8_STAGE(PG8_SA(1, 0), a3, voffA);
            PG8_BAR; PG8_WAIT_L(0); PG8_MMA(1, 0, At, B0); PG8_BAR; PG8_SCHED;
            PG8_STAGE(PG8_SB(1, 1), b3 + hstep, voffB);
            PG8_WAIT_V(6); PG8_BAR; PG8_MMA(1, 1, At, B1); PG8_BAR;
            }
        }
        if constexpr (ALIGN_EPI) { if (wr == 0) PG8_BAR; }
        if constexpr (!Epi::AFTER_DRAIN) { E(acc, cur, wr, wc, fr, fq); S.done(cur); }
        if (!has_next) break;
#pragma unroll
        for (int a = 0; a < 2; ++a)
#pragma unroll
            for (int b = 0; b < 2; ++b)
#pragma unroll
                for (int m = 0; m < 4; ++m)
#pragma unroll
                    for (int n = 0; n < 2; ++n) acc[a][b][m][n] = (f32x4){0.f, 0.f, 0.f, 0.f};
        cur = nxt; cA = nA; cB = nB; ++ui;
        if constexpr (ALIGN_EPI) { if (wr == 1) PG8_BAR; }
    }
    PG8_WAIT_V(0);
    if constexpr (!ALIGN_EPI) { if (wr == 0) PG8_BAR; }
    PG8_BAR;
    if constexpr (Epi::AFTER_DRAIN) { E.fused(acc, cur, wr, wc, fr, fq, lds, wid, lane); S.done(cur); }
#undef PG8_SA
#undef PG8_SB
#undef PG8_STAGE
#undef PG8_LDA
#undef PG8_LDB
#undef PG8_MMA
#undef PG8_WAIT_V
#undef PG8_WAIT_L
#undef PG8_BAR
#undef PG8_SCHED
}
}
#ifndef PG8_SP2
#define PG8_SP2 true
#endif
#ifndef PG8_ALIGN
#define PG8_ALIGN true
#endif
constexpr int NWAVES = 8;
constexpr int BATCH = 2, SEQ = 4096, DM = 2048, MTOK = BATCH * SEQ, DEPTH = 4, DFF = 5632, NGU = 2 * DFF, INC = 5656;
constexpr int NATN = 4352, VTN = 1536, NMOD = 9;
constexpr float RMS_EPS = 1e-6f;
constexpr float LOG2E = 1.4426950408889634f;
#ifndef MK_MULTI
#define MK_MULTI 0
#endif
constexpr size_t al256(size_t x) { return (x + 255) & ~(size_t)255; }
constexpr size_t WS_CTL = 0, CTL_ZERO_BYTES = 1u << 20;
constexpr size_t WS_MOD = CTL_ZERO_BYTES;
constexpr size_t WS_ROPE = al256(WS_MOD + (size_t)DEPTH * BATCH * NMOD * DM * 4);
constexpr size_t WS_BIAS1 = al256(WS_ROPE + (size_t)SEQ * 48 * 4);
constexpr size_t WS_LAM = al256(WS_BIAS1 + (size_t)DEPTH * 2 * 256 * 4);
constexpr size_t WS_WGU = al256(WS_LAM + 256);
constexpr size_t WS_WD = al256(WS_WGU + (size_t)DEPTH * 2 * NGU * DM * 2);
constexpr size_t WS_WNAT = al256(WS_WD + (size_t)DEPTH * 2 * DM * DFF * 2);
constexpr size_t WS_WV = al256(WS_WNAT + (size_t)DEPTH * NATN * DM * 2);
constexpr size_t WS_WO = al256(WS_WV + (size_t)DEPTH * VTN * DM * 2);
constexpr size_t WS_W1T = al256(WS_WO + (size_t)DEPTH * DM * DM * 2);
constexpr size_t WS_W2T = al256(WS_W1T + (size_t)DEPTH * 2 * 256 * 4096 * 2);
constexpr size_t WS_H = al256(WS_W2T + (size_t)DEPTH * 2 * 128 * 256 * 2);
constexpr size_t WS_ACT = al256(WS_H + (size_t)MTOK * DM * 2);
constexpr size_t WS_NAT = al256(WS_ACT + (size_t)MTOK * DFF * 2);
constexpr size_t WS_VTT = al256(WS_NAT + (size_t)32 * MTOK * 128 * 2);
constexpr size_t WS_KC = al256(WS_VTT + (size_t)VTN * MTOK * 2);
constexpr size_t WS_VCT = al256(WS_KC + (size_t)4 * 256 * 128 * 2);
constexpr size_t WS_GATES = al256(WS_VCT + (size_t)4 * 256 * 128 * 2);
constexpr size_t WS_OATT = al256(WS_GATES + (size_t)MTOK * 24 * 4);
constexpr size_t WS_END = al256(WS_OATT + (size_t)MTOK * DM * 2);
constexpr int CW_BAR = 4096;
constexpr int RING_OFF = 0, RING_BYTES = 131072;
constexpr int LDSCTL_OFF = RING_BYTES, MISC_OFF = LDSCTL_OFF + 320;
constexpr int LDS_BYTES = 147456;

#define GAS __attribute__((address_space(1)))
#define LAS __attribute__((address_space(3)))
typedef unsigned short bf16;
typedef unsigned v4u __attribute__((ext_vector_type(4)));
typedef unsigned v2u __attribute__((ext_vector_type(2)));
typedef float f32x4 __attribute__((ext_vector_type(4)));
typedef float f32x16 __attribute__((ext_vector_type(16)));
typedef short bf16x8 __attribute__((ext_vector_type(8)));
typedef GAS unsigned gu32;
#define RLX_AGENT __ATOMIC_RELAXED, __HIP_MEMORY_SCOPE_AGENT
#define LDS_WAIT() asm volatile("s_waitcnt lgkmcnt(0)" ::: "memory")
using pg8::cvtpk; using pg8::swap23;
__device__ __forceinline__ unsigned f2bf(float f) { unsigned u = __builtin_bit_cast(unsigned, f); return (u + 0x7fffu + ((u >> 16) & 1u)) >> 16; }
__device__ __forceinline__ unsigned pk2(float lo, float hi) { return f2bf(lo) | (f2bf(hi) << 16); }
__device__ __forceinline__ float ex2(float x) { return __builtin_amdgcn_exp2f(x); }
#define XB_TMO      128
#define XB_XCNT(j)  (256  + 64 * (j))
#define XB_XSUB(j)  (1280 + 64 * (j))
#define XB_XGEN(j)  (2304 + 64 * (j))
#define XB_TOP      3328
#define XB_TOPGEN   3392
#define XCD_BAR_WORDS 3456
#define XB_SPIN_CAP (1u << 18)

__device__ __forceinline__ unsigned xb_ld(unsigned* p)              { return __hip_atomic_load(p, __ATOMIC_RELAXED, __HIP_MEMORY_SCOPE_AGENT); }
__device__ __forceinline__ unsigned xb_add(unsigned* p, unsigned v) { return __hip_atomic_fetch_add(p, v, __ATOMIC_RELAXED, __HIP_MEMORY_SCOPE_AGENT); }
__device__ __forceinline__ unsigned xb_xcc_id() { return (unsigned)__builtin_amdgcn_s_getreg((3 << 11) | 20) & 0xFu; }
#define XB_SPIN(cond, bar) do { unsigned _sp = 0; while (cond) { __builtin_amdgcn_s_sleep(1); \
    if ((++_sp & 255u) == 0u) { if (xb_ld(&(bar)[XB_TMO])) break; if (_sp > XB_SPIN_CAP) { atomicAdd(&(bar)[XB_TMO], 1u); break; } } } } while (0)

struct XcdBarrier {
    unsigned* bar; unsigned x;
    volatile LAS unsigned* st;
};

__device__ __forceinline__ XcdBarrier xcd_barrier_post(unsigned* bar, volatile LAS unsigned* st) {
    XcdBarrier b; b.bar = bar; b.x = xb_xcc_id(); b.st = st;
    if (threadIdx.x == 0) (void)xb_add(&bar[XB_XCNT(b.x)], 1u);
    return b;
}
__device__ __forceinline__ void xcd_barrier_complete(unsigned* bar, unsigned x, unsigned& nloc, unsigned& nx) {
    const unsigned G = gridDim.x * gridDim.y * gridDim.z;
    unsigned sum, cnt, mine, sp = 0u;
    for (;;) {
        sum = 0u; cnt = 0u; mine = 0u;
#pragma unroll
        for (unsigned j = 0; j < 16; ++j) { const unsigned c = xb_ld(&bar[XB_XCNT(j)]); sum += c; cnt += (c > 0u) ? 1u : 0u; mine = (j == x) ? c : mine; }
        if (sum == G) break;
        __builtin_amdgcn_s_sleep(1);
        if ((++sp & 255u) == 0u) { if (xb_ld(&bar[XB_TMO])) break; if (sp > XB_SPIN_CAP) { atomicAdd(&bar[XB_TMO], 1u); break; } }
    }
    nloc = mine > 0u ? mine : 1u; nx = cnt > 0u ? cnt : 1u;
}

__device__ __forceinline__ void xcd_barrier(const XcdBarrier& b) {
    asm volatile("s_waitcnt vmcnt(0)" ::: "memory");
    __syncthreads();
    if (threadIdx.x == 0) {
        unsigned* bar = b.bar;
        __builtin_amdgcn_s_waitcnt(0);
        unsigned nloc = b.st[0], nx = b.st[1];
        if (nloc == 0u) { xcd_barrier_complete(bar, b.x, nloc, nx); b.st[0] = nloc; b.st[1] = nx; }
        const unsigned old = xb_add(&bar[XB_XSUB(b.x)], 1u);
        const unsigned gen = old / nloc;
        if (old + 1u == (gen + 1u) * nloc) {
            __builtin_amdgcn_fence(__ATOMIC_RELEASE, "agent");
            asm volatile("s_waitcnt vmcnt(0)" ::: "memory");
            const unsigned og = xb_add(&bar[XB_TOP], 1u);
            const unsigned tg = og / nx;
            if (og + 1u == (tg + 1u) * nx) xb_add(&bar[XB_TOPGEN], 1u);
            else XB_SPIN(xb_ld(&bar[XB_TOPGEN]) == tg, bar);
            __builtin_amdgcn_fence(__ATOMIC_ACQUIRE, "agent");
            xb_add(&bar[XB_XGEN(b.x)], 1u);
            asm volatile("s_waitcnt vmcnt(0)" ::: "memory");
        } else {
            XB_SPIN(xb_ld(&bar[XB_XGEN(b.x)]) == gen, bar);
            __builtin_amdgcn_fence(__ATOMIC_ACQUIRE, "agent");
            asm volatile("s_waitcnt vmcnt(0)" ::: "memory");
        }
    }
    __syncthreads();
}
struct Params {
    const float *x, *c, *w_ada, *b_ada, *norm_g, *w_gu, *w_d, *w_in, *w_o, *diff_lam, *diff_subln, *cmp_pe, *cmp_w1, *cmp_w2, *final_g;
    float* out; unsigned char* ws; int one_it, one_ph;
};
__device__ __forceinline__ float wave_sum(float v) {
#pragma unroll
    for (int o = 1; o < 64; o <<= 1) v += __shfl_xor(v, o);
    return v;
}
__device__ __forceinline__ void transpose_item(const float* W, size_t ldw, int K, int k0, int n0, bf16* WT, int dst_row, LAS float* scr, int lane) {
#pragma unroll 8
    for (int i = 0; i < 32; ++i) { const int kk = 2 * i + (lane >> 5); scr[kk * 33 + (lane & 31)] = W[(size_t)(k0 + kk) * ldw + n0 + (lane & 31)]; }
    LDS_WAIT(); asm volatile("" ::: "memory");
    const int c = lane & 7;
#pragma unroll
    for (int j = 0; j < 4; ++j) { const int n = (lane >> 3) + 8 * j; const LAS float* s = scr + (8 * c) * 33 + n;
        v4u o; o.x = pk2(s[0 * 33], s[1 * 33]); o.y = pk2(s[2 * 33], s[3 * 33]); o.z = pk2(s[4 * 33], s[5 * 33]); o.w = pk2(s[6 * 33], s[7 * 33]);
        *(v4u*)(WT + (size_t)(dst_row + n) * K + k0 + 8 * c) = o; }
    LDS_WAIT(); asm volatile("" ::: "memory");
}
__device__ __forceinline__ void transpose_cols(const float* W, size_t ldw, int K, int ncols, int map, bf16* WT, int dst0, LAS float* scr, int gw, int NGW, int lane) {
    const int nblk = ncols / 32, nitems = (K / 64) * nblk;
    for (int it = gw; it < nitems; it += NGW) {
        const int kb = it / nblk, nb = it % nblk, n0 = nb * 32;
        int dr = dst0 + n0;
        if (map == 1) { const int n = n0 < DFF ? n0 : n0 - DFF; dr = 256 * (n >> 7) + (n & 127) + (n0 < DFF ? 0 : 128); }
        transpose_item(W, ldw, K, kb * 64, n0, WT, dr, scr, lane);
    }
}
template <int NB, bool SILU>
__device__ __forceinline__ void gemv_unit(const float* W, size_t ldw, int K, const float* vec, size_t vstride, float* out, size_t ostride, const float* bias, LAS unsigned char* lds, int tid, int wave, int lane) {
    LAS float* vs = (LAS float*)lds;
    LAS float* part = (LAS float*)(lds + 32768);
    for (int i = tid; i < NB * K; i += NWAVES * 64) { const int b = i / K, k = i % K; float v = vec[(size_t)b * vstride + k]; if (SILU) v = v / (1.0f + __expf(-v)); vs[i] = v; }
    __syncthreads();
    f32x4 acc[NB];
#pragma unroll
    for (int b = 0; b < NB; ++b) acc[b] = (f32x4){0.f, 0.f, 0.f, 0.f};
    const int kc = K / NWAVES, kbeg = wave * kc;
    const float* wp = W + (size_t)kbeg * ldw + 4 * lane;
#pragma unroll 8
    for (int k = 0; k < kc; ++k) { const f32x4 wv = *(const f32x4*)(wp + (size_t)k * ldw);
#pragma unroll
        for (int b = 0; b < NB; ++b) acc[b] += vs[b * K + kbeg + k] * wv; }
#pragma unroll
    for (int b = 0; b < NB; ++b) *(LAS f32x4*)(part + (wave * NB + b) * 256 + 4 * lane) = acc[b];
    __syncthreads();
    if (tid < NB * 256) { const int b = tid >> 8, n = tid & 255; float s = bias ? bias[n] : 0.f;
#pragma unroll
        for (int w = 0; w < NWAVES; ++w) s += part[(w * NB + b) * 256 + n];
        out[(size_t)b * ostride + n] = s; }
    __syncthreads();
}
__device__ __forceinline__ void prologue(const Params& p, LAS unsigned char* lds, int bid, int G, int tid, int wave, int lane) {
    unsigned char* ws = p.ws;
    const int gw = bid * NWAVES + wave, NGW = G * NWAVES;
    for (int u = bid; u < 288 + 8; u += G) {
        if (u < 288) { const int l = u / 72, n0 = (u % 72) * 256;
            gemv_unit<2, true>(p.w_ada + (size_t)l * DM * (NMOD * DM) + n0, (size_t)NMOD * DM, DM, p.c, DM, (float*)(ws + WS_MOD) + (size_t)l * 2 * NMOD * DM + n0, (size_t)NMOD * DM, p.b_ada + (size_t)l * NMOD * DM + n0, lds, tid, wave, lane);
        } else { const int lj = u - 288;
            gemv_unit<1, false>(p.cmp_w1 + (size_t)lj * 4096 * 256, 256, 4096, p.cmp_pe + (size_t)lj * 4096, 0, (float*)(ws + WS_BIAS1) + lj * 256, 0, nullptr, lds, tid, wave, lane);
        }
    }
    { const f32x4* s = (const f32x4*)p.x; f32x4* d = (f32x4*)p.out; const size_t n4 = (size_t)MTOK * DM / 4;
      for (size_t i = (size_t)bid * (NWAVES * 64) + tid; i < n4; i += (size_t)G * (NWAVES * 64)) d[i] = s[i]; }
    { float* rp = (float*)(ws + WS_ROPE);
      for (int i = bid * (NWAVES * 64) + tid; i < SEQ * 24; i += G * (NWAVES * 64)) { const int t = i / 24, k = i % 24;
          const int half = k < 8 ? 8 : 16, ii = k < 8 ? k : k - 8;
          const float inv = expf((-13.122363377404328f * (float)ii) / (float)half), ang = (float)t * inv;
          const float cs = cosf(ang), sn = sinf(ang);
          if (k < 8) { rp[t * 48 + ii] = cs; rp[t * 48 + 8 + ii] = sn; } else { rp[t * 48 + 16 + ii] = cs; rp[t * 48 + 32 + ii] = sn; } } }
    if (bid == 0 && tid < DEPTH) { const float* lf = p.diff_lam + tid * 4 * 64; float s01 = 0.f, s23 = 0.f;
        for (int i = 0; i < 64; ++i) { s01 += lf[i] * lf[64 + i]; s23 += lf[128 + i] * lf[192 + i]; }
        const float li = 0.8f - 0.6f * expf(-0.3f * (float)tid);
        float* o = (float*)(ws + WS_LAM) + tid * 2; o[0] = expf(s01) - expf(s23) + li; o[1] = 1.0f - li; }
    for (int i = bid * (NWAVES * 64) + tid; i < DEPTH * 24 * DM; i += G * (NWAVES * 64)) { const int l = i / (24 * DM), r = i % (24 * DM), cidx = r / DM, k = r % DM;
        ((bf16*)(ws + WS_WNAT))[((size_t)l * NATN + 4096 + cidx) * DM + k] = (bf16)f2bf(p.w_in[((size_t)l * DM + k) * INC + 5632 + cidx]); }
    LAS float* scr = (LAS float*)(lds + wave * 16384);
    for (int l = 0; l < DEPTH; ++l) {
        for (int f = 0; f < 2; ++f) {
            transpose_cols(p.w_gu + (size_t)(l * 2 + f) * DM * NGU, NGU, DM, NGU, 1, (bf16*)(ws + WS_WGU) + (size_t)(l * 2 + f) * NGU * DM, 0, scr, gw, NGW, lane);
            transpose_cols(p.w_d + (size_t)(l * 2 + f) * DFF * DM, DM, DFF, DM, 0, (bf16*)(ws + WS_WD) + (size_t)(l * 2 + f) * DM * DFF, 0, scr, gw, NGW, lane);
            transpose_cols(p.cmp_w1 + (size_t)(l * 2 + f) * 4096 * 256, 256, 4096, 256, 0, (bf16*)(ws + WS_W1T) + (size_t)(l * 2 + f) * 256 * 4096, 0, scr, gw, NGW, lane);
            transpose_cols(p.cmp_w2 + (size_t)(l * 2 + f) * 256 * 128, 128, 256, 128, 0, (bf16*)(ws + WS_W2T) + (size_t)(l * 2 + f) * 128 * 256, 0, scr, gw, NGW, lane);
        }
        const float* wi = p.w_in + (size_t)l * DM * INC; bf16* wn = (bf16*)(ws + WS_WNAT) + (size_t)l * NATN * DM; bf16* wv = (bf16*)(ws + WS_WV) + (size_t)l * VTN * DM;
        transpose_cols(wi + 0, INC, DM, 1024, 0, wn, 0, scr, gw, NGW, lane);
        transpose_cols(wi + 1024, INC, DM, 1024, 0, wn, 1024, scr, gw, NGW, lane);
        transpose_cols(wi + 2048, INC, DM, 1024, 0, wv, 0, scr, gw, NGW, lane);
        transpose_cols(wi + 3072, INC, DM, 1024, 0, wn, 2048, scr, gw, NGW, lane);
        transpose_cols(wi + 4096, INC, DM, 256, 0, wn, 3072, scr, gw, NGW, lane);
        transpose_cols(wi + 4352, INC, DM, 256, 0, wn, 3328, scr, gw, NGW, lane);
        transpose_cols(wi + 4608, INC, DM, 256, 0, wn, 3584, scr, gw, NGW, lane);
        transpose_cols(wi + 4864, INC, DM, 256, 0, wv, 1024, scr, gw, NGW, lane);
        transpose_cols(wi + 5120, INC, DM, 256, 0, wn, 3840, scr, gw, NGW, lane);
        transpose_cols(wi + 5376, INC, DM, 256, 0, wv, 1280, scr, gw, NGW, lane);
        transpose_cols(p.w_o + (size_t)l * DM * DM, DM, DM, DM, 0, (bf16*)(ws + WS_WO) + (size_t)l * DM * DM, 0, scr, gw, NGW, lane);
    }
}
__device__ __forceinline__ void norm_phase(const float* x, const float* g, const float* shift, const float* scale, size_t bstride, bf16* h, int gw, int NGW, int lane) {
    for (int m = gw; m < MTOK; m += NGW) {
        const int b = m >> 12;
        const f32x4* xr = (const f32x4*)(x + (size_t)m * DM) + lane;
        f32x4 v[8]; float s = 0.f;
#pragma unroll
        for (int j = 0; j < 8; ++j) { v[j] = xr[64 * j]; s += (v[j].x * v[j].x + v[j].y * v[j].y) + (v[j].z * v[j].z + v[j].w * v[j].w); }
        const float rstd = rsqrtf(wave_sum(s) * (1.f / DM) + RMS_EPS);
        const f32x4* gp = (const f32x4*)g + lane; const f32x4* sh = (const f32x4*)(shift + (size_t)b * bstride) + lane; const f32x4* sc = (const f32x4*)(scale + (size_t)b * bstride) + lane;
        v2u* o = (v2u*)(h + (size_t)m * DM) + lane;
#pragma unroll
        for (int j = 0; j < 8; ++j) { const f32x4 y = (v[j] * rstd) * gp[64 * j] * (sc[64 * j] + 1.0f) + sh[64 * j];
            v2u w; w.x = cvtpk(y.x, y.y); w.y = cvtpk(y.z, y.w); o[64 * j] = w; }
    }
}
__device__ __forceinline__ void final_norm_phase(float* x, const float* g, int gw, int NGW, int lane) {
    for (int m = gw; m < MTOK; m += NGW) {
        f32x4* xr = (f32x4*)(x + (size_t)m * DM) + lane;
        f32x4 v[8]; float s = 0.f;
#pragma unroll
        for (int j = 0; j < 8; ++j) { v[j] = xr[64 * j]; s += (v[j].x * v[j].x + v[j].y * v[j].y) + (v[j].z * v[j].z + v[j].w * v[j].w); }
        const float rstd = rsqrtf(wave_sum(s) * (1.f / DM) + RMS_EPS);
        const f32x4* gp = (const f32x4*)g + lane;
#pragma unroll
        for (int j = 0; j < 8; ++j) xr[64 * j] = (v[j] * rstd) * gp[64 * j];
    }
}
#define MFMA16(a, b, c) __builtin_amdgcn_mfma_f32_16x16x32_bf16((a), (b), (c), 0, 0, 0)
#define MFMA32(a, b, c) __builtin_amdgcn_mfma_f32_32x32x16_bf16((a), (b), (c), 0, 0, 0)
__device__ __forceinline__ bf16x8 ldg8(const bf16* p) { return *(const bf16x8*)p; }
__device__ __forceinline__ void compress_unit(const Params& p, int layer, int u, LAS unsigned char* lds, int tid, int wave, int lane) {
    unsigned char* ws = p.ws;
    const int jj = u >> 6, b = (u >> 5) & 1, g = (u >> 4) & 1, n0 = (u & 15) * 16;
    const bf16* A = (const bf16*)(ws + WS_NAT) + (size_t)((24 + 2 * jj + g) * 2 + b) * (4096 * 128);
    const bf16* W1 = (const bf16*)(ws + WS_W1T) + (size_t)(layer * 2 + jj) * 256 * 4096;
    const bf16* W2 = (const bf16*)(ws + WS_W2T) + (size_t)(layer * 2 + jj) * 128 * 256;
    const float* b1 = (const float*)(ws + WS_BIAS1) + (layer * 2 + jj) * 256;
    const int r16 = lane & 15, kq = lane >> 4;
    int nr = n0 + r16; if (nr > 254) nr = 254;
    const bf16* ap = A + (size_t)nr * 2048 + 8 * kq;
    const bf16* bp0 = W1 + (size_t)(32 * wave + r16) * 4096 + 8 * kq; const bf16* bp1 = bp0 + 16 * 4096;
    f32x4 acc0 = {0.f, 0.f, 0.f, 0.f}, acc1 = {0.f, 0.f, 0.f, 0.f};
#pragma unroll 8
    for (int ks = 0; ks < 128; ++ks) { const bf16x8 a = ldg8(ap + 32 * ks), w0 = ldg8(bp0 + 32 * ks), w1 = ldg8(bp1 + 32 * ks); acc0 = MFMA16(a, w0, acc0); acc1 = MFMA16(a, w1, acc1); }
    LAS bf16* Hs = (LAS bf16*)lds;
#pragma unroll
    for (int i = 0; i < 4; ++i) { const int row = 4 * kq + i, col = 32 * wave + r16;
        Hs[row * 264 + col] = (bf16)f2bf(pg8::silu_f(acc0[i] + b1[col])); Hs[row * 264 + col + 16] = (bf16)f2bf(pg8::silu_f(acc1[i] + b1[col + 16])); }
    __syncthreads();
    f32x4 acc = {0.f, 0.f, 0.f, 0.f};
    const bf16* wp = W2 + (size_t)(16 * wave + r16) * 256 + 8 * kq;
#pragma unroll
    for (int ks = 0; ks < 8; ++ks) { const bf16x8 a = *(const LAS bf16x8*)(Hs + r16 * 264 + 32 * ks + 8 * kq); acc = MFMA16(a, ldg8(wp + 32 * ks), acc); }
    const int dcol = 16 * wave + r16;
#pragma unroll
    for (int i = 0; i < 4; ++i) { const int n = n0 + 4 * kq + i; const bf16 val = (bf16)(n <= 254 ? f2bf(acc[i]) : 0u);
        if (jj == 0) ((bf16*)(ws + WS_KC))[(size_t)(b * 2 + g) * (256 * 128) + ((size_t)((((n >> 5) * 8 + (dcol >> 4)) * 64) + (((dcol >> 3) & 1) * 32 + swap23(n & 31)))) * 8 + (dcol & 7)] = val;
        else ((bf16*)(ws + WS_VCT))[(size_t)(b * 2 + g) * (256 * 128) + ((size_t)(((((dcol >> 5) * 8 + (n >> 5)) * 2 + ((n >> 4) & 1)) * 64) + ((n >> 3) & 1) * 32 + (dcol & 31))) * 8 + (n & 7)] = val; }
    __syncthreads();
}
__device__ __forceinline__ unsigned mask_le(int kbase, int lim) { unsigned r = 0;
#pragma unroll
    for (int i = 0; i < 16; ++i) r |= (unsigned)((kbase + (i & 7) + 16 * (i >> 3)) <= lim) << i;
    return r; }
__device__ __forceinline__ unsigned mask_ge(int kbase, int lim) { unsigned r = 0;
#pragma unroll
    for (int i = 0; i < 16; ++i) r |= (unsigned)((kbase + (i & 7) + 16 * (i >> 3)) >= lim) << i;
    return r; }
template <int NSTEP>
__device__ __forceinline__ f32x16 qk_tile(const bf16* kp, const bf16x8 (&qf)[NSTEP]) {
    f32x16 s;
#pragma unroll
    for (int i = 0; i < 16; ++i) s[i] = 0.f;
#pragma unroll
    for (int st = 0; st < NSTEP; ++st) s = MFMA32(ldg8(kp + st * 512), qf[st], s);
    return s;
}
__device__ __forceinline__ void stat_update(float& m, float& l, const f32x16& s, unsigned allow) {
    float tm = -1e30f;
#pragma unroll
    for (int i = 0; i < 16; ++i) tm = fmaxf(tm, ((allow >> i) & 1u) ? s[i] : -1e30f);
    tm = fmaxf(tm, __shfl_xor(tm, 32));
    const float mn = fmaxf(m, tm);
    float a = 0.f;
#pragma unroll
    for (int i = 0; i < 16; ++i) a += ((allow >> i) & 1u) ? ex2(s[i] - mn) : 0.f;
    l = l * ex2(m - mn) + a; m = mn;
}
__device__ __forceinline__ bf16x8 pack8(float a0, float a1, float a2, float a3, float a4, float a5, float a6, float a7) {
    v4u w; w.x = cvtpk(a0, a1); w.y = cvtpk(a2, a3); w.z = cvtpk(a4, a5); w.w = cvtpk(a6, a7); return __builtin_bit_cast(bf16x8, w); }
__device__ __forceinline__ void pv_tile(f32x16 (&o)[4], const bf16* vp, int dtstride, const bf16x8 pf0, const bf16x8 pf1) {
#pragma unroll
    for (int dt = 0; dt < 4; ++dt) { o[dt] = MFMA32(ldg8(vp + (size_t)dt * dtstride), pf0, o[dt]); o[dt] = MFMA32(ldg8(vp + (size_t)dt * dtstride + 512), pf1, o[dt]); }
}
__device__ __forceinline__ void imp_accum(const float (&pn)[16], int T, int j, int h, LAS float* row) {
    float ps[16];
#pragma unroll
    for (int i = 0; i < 16; ++i) { float v = pn[i]; v += __shfl_xor(v, 1); v += __shfl_xor(v, 2); ps[i] = v; }
    const float eA0 = ps[0] + ps[1] + ps[2] + 0.5f * ps[3], eA1 = 0.5f * ps[3] + ps[4] + ps[5] + ps[6] + 0.5f * ps[7], eA2 = 0.5f * ps[7];
    const float eB0 = ps[8] + ps[9] + ps[10] + 0.5f * ps[11], eB1 = 0.5f * ps[11] + ps[12] + ps[13] + ps[14] + 0.5f * ps[15], eB2 = 0.5f * ps[15];
    const int bA = 8 * T + 2 * h, bB = bA + 4;
    if (j == 0 && h == 0) { row[bA] += eA0; row[bA + 1] += eA1; row[bA + 2] += eA2; row[bB] += eB0; row[bB + 1] += eB1; row[bB + 2] += eB2; }
    LDS_WAIT(); asm volatile("" ::: "memory");
    if (j == 0 && h == 1) { row[bA] += eA0; row[bA + 1] += eA1; row[bA + 2] += eA2; row[bB] += eB0; row[bB + 1] += eB1; row[bB + 2] += eB2; }
    LDS_WAIT(); asm volatile("" ::: "memory");
}
template <bool IMP, class MaskF>
__device__ __forceinline__ void nsa_branch(const bf16* kt, const bf16* vt, int dtstride, int T0, int T1, const bf16x8 (&qf)[8], const MaskF& mf, float gate, f32x16 (&o)[4], LAS float* improw, int j, int h) {
    float m = -1e30f, l = 0.f;
    for (int T = T0; T <= T1; ++T) { const unsigned allow = mf(T); if (!__any(allow != 0u)) continue;
        const f32x16 s = qk_tile<8>(kt + (size_t)T * 4096, qf); stat_update(m, l, s, allow); }
    l += __shfl_xor(l, 32);
    const float inv = l > 0.f ? 1.0f / l : 0.f;
    for (int T = T0; T <= T1; ++T) { const unsigned allow = mf(T); if (!__any(allow != 0u)) continue;
        const f32x16 s = qk_tile<8>(kt + (size_t)T * 4096, qf);
        float pn[16];
#pragma unroll
        for (int i = 0; i < 16; ++i) pn[i] = ((allow >> i) & 1u) ? ex2(s[i] - m) * inv : 0.f;
        if (IMP) imp_accum(pn, T, j, h, improw);
        const bf16x8 pf0 = pack8(pn[0] * gate, pn[1] * gate, pn[2] * gate, pn[3] * gate, pn[4] * gate, pn[5] * gate, pn[6] * gate, pn[7] * gate);
        const bf16x8 pf1 = pack8(pn[8] * gate, pn[9] * gate, pn[10] * gate, pn[11] * gate, pn[12] * gate, pn[13] * gate, pn[14] * gate, pn[15] * gate);
        pv_tile(o, vt + (size_t)T * 1024, dtstride, pf0, pf1); }
}
__device__ __forceinline__ void nsa_unit(const Params& p, int u, LAS unsigned char* lds, int wave, int lane) {
    unsigned char* ws = p.ws;
    const int bg = u & 3, b = bg >> 1, g = bg & 1, pi = u >> 2;
    const int tb = (wave >> 2) ? 127 - pi : pi, t0w = 32 * tb + 8 * (wave & 3);
    const int c = lane & 31, h = lane >> 5, ti = c >> 2, j = c & 3, t = t0w + ti, head = 4 * g + j;
    const float* gt = (const float*)(ws + WS_GATES) + (size_t)(b * 4096 + t) * 24 + head * 3;
    const float g_c = gt[0], g_s = gt[1], g_w = gt[2];
    const bf16* nat = (const bf16*)(ws + WS_NAT);
    const bf16* qb = nat + (size_t)((16 + head) * 2 + b) * (4096 * 128);
    bf16x8 qf[8];
#pragma unroll
    for (int st = 0; st < 8; ++st) qf[st] = ldg8(qb + ((size_t)(((t >> 5) * 8 + st) * 64 + h * 32 + (t & 31))) * 8);
    f32x16 o[4];
#pragma unroll
    for (int dt = 0; dt < 4; ++dt)
#pragma unroll
        for (int i = 0; i < 16; ++i) o[dt][i] = 0.f;
    LAS float* imp = (LAS float*)(lds + wave * 2304);
    LAS unsigned* selm = (LAS unsigned*)(lds + 8 * 2304 + wave * 64);
    for (int i = lane; i < 8 * 68; i += 64) imp[i] = 0.f;
    LDS_WAIT(); asm volatile("" ::: "memory");
    {
        const int nv = t >= 31 ? ((t - 31) >> 4) + 1 : 0;
        const int nvmax = (t0w + 7) >= 31 ? ((t0w + 7 - 31) >> 4) + 1 : 0;
        const int NT = (nvmax + 31) >> 5;
        const bf16* kt = (const bf16*)(ws + WS_KC) + (size_t)(b * 2 + g) * (256 * 128) + lane * 8;
        const bf16* vt = (const bf16*)(ws + WS_VCT) + (size_t)(b * 2 + g) * (256 * 128) + lane * 8;
        auto mf = [=](int T) -> unsigned { return mask_le(32 * T + 8 * h, nv - 1); };
        nsa_branch<true>(kt, vt, 8 * 1024, 0, NT - 1, qf, mf, g_c, o, imp + ti * 68, j, h);
    }
    {
        const int tk = lane >> 3, sub = lane & 7, cur = t0w >> 6;
        const LAS float* row = imp + tk * 68;
        float sc[8]; int rank[8];
#pragma unroll
        for (int e = 0; e < 8; ++e) { const int mm = sub * 8 + e; const bool valid = mm <= cur, forced = (mm == 0) || (mm == cur) || (mm == cur - 1);
            sc[e] = valid ? (forced ? 3.0e38f : row[mm]) : -1.0f; rank[e] = 0; }
#pragma unroll 4
        for (int mp = 0; mp < 64; ++mp) { const bool validp = mp <= cur, forcedp = (mp == 0) || (mp == cur) || (mp == cur - 1);
            const float sp = validp ? (forcedp ? 3.0e38f : row[mp]) : -1.0f;
#pragma unroll
            for (int e = 0; e < 8; ++e) { const int mm = sub * 8 + e; rank[e] += ((sp > sc[e]) || (sp == sc[e] && mp < mm)) ? 1 : 0; } }
        unsigned byte = 0;
#pragma unroll
        for (int e = 0; e < 8; ++e) byte |= (unsigned)((sc[e] >= 0.f) && (rank[e] < 16)) << e;
        unsigned lo = sub < 4 ? byte << (8 * sub) : 0u, hi = sub >= 4 ? byte << (8 * (sub - 4)) : 0u;
        lo |= __shfl_xor(lo, 1); lo |= __shfl_xor(lo, 2); lo |= __shfl_xor(lo, 4);
        hi |= __shfl_xor(hi, 1); hi |= __shfl_xor(hi, 2); hi |= __shfl_xor(hi, 4);
        if (sub == 0) { selm[tk * 2] = lo; selm[tk * 2 + 1] = hi; }
        LDS_WAIT(); asm volatile("" ::: "memory");
    }
    const unsigned slo = selm[ti * 2], shi = selm[ti * 2 + 1];
    {
        const int cur = t0w >> 6;
        const bf16* kt = nat + (size_t)((28 + g) * 2 + b) * (4096 * 128) + lane * 8;
        const bf16* vt = (const bf16*)(ws + WS_VTT) + ((size_t)((8 + g) * 4) * 256 + b * 128) * 1024 + lane * 8;
        auto mf = [=](int T) -> unsigned { const int blk = T >> 1; const unsigned bit = blk < 32 ? (slo >> blk) & 1u : (shi >> (blk - 32)) & 1u;
            if (!bit) return 0u; return blk == cur ? mask_le(32 * T + 8 * h, t) : 0xFFFFu; };
        nsa_branch<false>(kt, vt, 256 * 1024, 0, 2 * cur + 1, qf, mf, g_s, o, imp, j, h);
    }
    {
        const int T0 = (t0w - 511 > 0 ? t0w - 511 : 0) >> 5, T1 = (t0w + 7) >> 5;
        const bf16* kt = nat + (size_t)((30 + g) * 2 + b) * (4096 * 128) + lane * 8;
        const bf16* vt = (const bf16*)(ws + WS_VTT) + ((size_t)((10 + g) * 4) * 256 + b * 128) * 1024 + lane * 8;
        auto mf = [=](int T) -> unsigned { const int kb = 32 * T + 8 * h; return mask_le(kb, t) & mask_ge(kb, t - 511); };
        nsa_branch<false>(kt, vt, 256 * 1024, T0, T1, qf, mf, g_w, o, imp, j, h);
    }
    bf16* op = (bf16*)(ws + WS_OATT) + (size_t)(b * 4096 + t) * DM + 1024 + head * 128 + 4 * h;
#pragma unroll
    for (int dt = 0; dt < 4; ++dt)
#pragma unroll
        for (int ig = 0; ig < 4; ++ig) { v2u w; w.x = cvtpk(o[dt][4 * ig], o[dt][4 * ig + 1]); w.y = cvtpk(o[dt][4 * ig + 2], o[dt][4 * ig + 3]); *(v2u*)(op + 32 * dt + 8 * ig) = w; }
}
__device__ __forceinline__ void diff_unit(const Params& p, int layer, int u, int wave, int lane) {
    unsigned char* ws = p.ws;
    const int bh = u & 15, b = bh >> 3, head = bh & 7, qi = u >> 4;
    const int qb128 = (wave >> 2) ? 31 - qi : qi, q0 = 128 * qb128 + 32 * (wave & 3);
    const int c = lane & 31, h = lane >> 5, t = q0 + c, Td = q0 >> 5;
    const bf16* nat = (const bf16*)(ws + WS_NAT);
    const bf16* qb = nat + (size_t)(head * 2 + b) * (4096 * 128);
    bf16x8 qf0[4], qf1[4];
#pragma unroll
    for (int st = 0; st < 4; ++st) { qf0[st] = ldg8(qb + ((size_t)(((t >> 5) * 8 + st) * 64 + h * 32 + (t & 31))) * 8); qf1[st] = ldg8(qb + ((size_t)(((t >> 5) * 8 + 4 + st) * 64 + h * 32 + (t & 31))) * 8); }
    const bf16* kt = nat + (size_t)((8 + head) * 2 + b) * (4096 * 128) + lane * 8;
    const bf16* vt = (const bf16*)(ws + WS_VTT) + ((size_t)(head * 4) * 256 + b * 128) * 1024 + lane * 8;
    float m0 = -1e30f, l0 = 0.f, m1 = -1e30f, l1 = 0.f;
    for (int T = 0; T <= Td; ++T) { const unsigned allow = T == Td ? mask_le(32 * T + 8 * h, t) : 0xFFFFu;
        const f32x16 s0 = qk_tile<4>(kt + (size_t)T * 4096, qf0); stat_update(m0, l0, s0, allow);
        const f32x16 s1 = qk_tile<4>(kt + (size_t)T * 4096 + 2048, qf1); stat_update(m1, l1, s1, allow); }
    l0 += __shfl_xor(l0, 32); l1 += __shfl_xor(l1, 32);
    const float* lm = (const float*)(ws + WS_LAM) + layer * 2;
    const float il0 = 1.0f / l0, il1 = lm[0] / l1;
    f32x16 o[4];
#pragma unroll
    for (int dt = 0; dt < 4; ++dt)
#pragma unroll
        for (int i = 0; i < 16; ++i) o[dt][i] = 0.f;
    for (int T = 0; T <= Td; ++T) { const unsigned allow = T == Td ? mask_le(32 * T + 8 * h, t) : 0xFFFFu;
        const f32x16 s0 = qk_tile<4>(kt + (size_t)T * 4096, qf0); const f32x16 s1 = qk_tile<4>(kt + (size_t)T * 4096 + 2048, qf1);
        float a[16];
#pragma unroll
        for (int i = 0; i < 16; ++i) a[i] = ((allow >> i) & 1u) ? ex2(s0[i] - m0) * il0 - ex2(s1[i] - m1) * il1 : 0.f;
        pv_tile(o, vt + (size_t)T * 1024, 256 * 1024, pack8(a[0], a[1], a[2], a[3], a[4], a[5], a[6], a[7]), pack8(a[8], a[9], a[10], a[11], a[12], a[13], a[14], a[15])); }
    float ss = 0.f;
#pragma unroll
    for (int dt = 0; dt < 4; ++dt)
#pragma unroll
        for (int i = 0; i < 16; ++i) ss += o[dt][i] * o[dt][i];
    ss += __shfl_xor(ss, 32);
    const float r = rsqrtf(ss * (1.0f / 128.0f) + RMS_EPS) * lm[1];
    const float* sg = p.diff_subln + layer * 128 + 4 * h;
    bf16* op = (bf16*)(ws + WS_OATT) + (size_t)(b * 4096 + t) * DM + head * 128 + 4 * h;
#pragma unroll
    for (int dt = 0; dt < 4; ++dt)
#pragma unroll
        for (int ig = 0; ig < 4; ++ig) { const f32x4 gv = *(const f32x4*)(sg + 32 * dt + 8 * ig);
            v2u w; w.x = cvtpk(o[dt][4 * ig] * r * gv[0], o[dt][4 * ig + 1] * r * gv[1]); w.y = cvtpk(o[dt][4 * ig + 2] * r * gv[2], o[dt][4 * ig + 3] * r * gv[3]); *(v2u*)(op + 32 * dt + 8 * ig) = w; }
}
#define LAUNDER_V(x) asm volatile("" : "+v"(x))
#define LAUNDER_S(x) asm volatile("" : "+s"(x))
template <int PH>
__device__ __forceinline__ void run_phase(int it, LAS unsigned char* lds) {
    const __attribute__((address_space(4))) Params* pp_ = (const __attribute__((address_space(4))) Params*)__builtin_amdgcn_kernarg_segment_ptr(); LAUNDER_S(pp_);
#if defined(__HIP_DEVICE_COMPILE__)
    const Params p = *pp_;
#else
    const Params p{};
#endif
    int tid = threadIdx.x; LAUNDER_V(tid);
    int bid = blockIdx.x, G = gridDim.x; LAUNDER_S(bid); LAUNDER_S(G);
    unsigned char* ws = p.ws; LAUNDER_S(ws);
    const int lane = tid & 63, wave = __builtin_amdgcn_readfirstlane(tid >> 6), gw = bid * NWAVES + wave, NGW = G * NWAVES;
    const int l = it >> 1, f = it & 1, sub = f ? 2 : 0;
    const float* modl = (const float*)(ws + WS_MOD) + (size_t)l * 2 * NMOD * DM;
    bf16* const H = (bf16*)(ws + WS_H); bf16* const ACT = (bf16*)(ws + WS_ACT); bf16* const OATT = (bf16*)(ws + WS_OATT);
    float* const X = p.out;
    if constexpr (PH == 8) prologue(p, lds, bid, G, tid, wave, lane);
    if constexpr (PH == 9) final_norm_phase(X, p.final_g, gw, NGW, lane);
    if constexpr (PH == 0) norm_phase(X, p.norm_g + (size_t)(l * 3 + sub) * DM, modl + (3 * sub) * DM, modl + (3 * sub + 1) * DM, (size_t)NMOD * DM, H, gw, NGW, lane);
    if constexpr (PH == 3) norm_phase(X, p.norm_g + (size_t)(l * 3 + 1) * DM, modl + 3 * DM, modl + 4 * DM, (size_t)NMOD * DM, H, gw, NGW, lane);
    if constexpr (PH == 1) {
        pg8::Gemm g{H, (const bf16*)(ws + WS_WGU) + (size_t)(l * 2 + f) * NGU * DM, MTOK, NGU, DM}; pg8::StaticOrder S; S.init(MTOK, NGU, G, bid);
        pg8::EpiSwiglu E{ACT, DFF};
        pg8::gemm_phase<pg8::EpiSwiglu, pg8::StaticOrder, PG8_ALIGN, PG8_SP2>(lds + RING_OFF, g, S, E);
    }
    if constexpr (PH == 2) {
        pg8::Gemm g{ACT, (const bf16*)(ws + WS_WD) + (size_t)(l * 2 + f) * DM * DFF, MTOK, DM, DFF}; pg8::StaticOrder S; S.init(MTOK, DM, G, bid);
        pg8::EpiResid E{X, modl + (3 * sub + 2) * DM, NMOD * DM, 0.5f};
        pg8::gemm_phase<pg8::EpiResid, pg8::StaticOrder, PG8_ALIGN, PG8_SP2>(lds + RING_OFF, g, S, E);
    }
    if constexpr (PH == 4) {
        { pg8::Gemm g{H, (const bf16*)(ws + WS_WNAT) + (size_t)l * NATN * DM, MTOK, NATN, DM}; pg8::StaticOrder S; S.init(MTOK, NATN, G, bid);
          pg8::EpiNat E{(bf16*)(ws + WS_NAT), (float*)(ws + WS_GATES), (const float*)(ws + WS_ROPE), 0.125f * LOG2E, 0.08838834764831845f * LOG2E};
          pg8::gemm_phase<pg8::EpiNat, pg8::StaticOrder, PG8_ALIGN, PG8_SP2>(lds + RING_OFF, g, S, E); }
        { pg8::Gemm g{(const bf16*)(ws + WS_WV) + (size_t)l * VTN * DM, H, VTN, MTOK, DM}; pg8::StaticOrder S; S.init(VTN, MTOK, G, G - 1 - bid);
          pg8::EpiVT E{(bf16*)(ws + WS_VTT)};
          pg8::gemm_phase<pg8::EpiVT, pg8::StaticOrder, PG8_ALIGN, PG8_SP2>(lds + RING_OFF, g, S, E); }
    }
    if constexpr (PH == 5) {
        for (int u = bid; u < 128; u += G) compress_unit(p, l, u, lds, tid, wave, lane);
        for (int u = bid; u < 256; u += G) diff_unit(p, l, u, wave, lane);
    }
    if constexpr (PH == 6) { for (int u = bid; u < 256; u += G) nsa_unit(p, u, lds, wave, lane); }
    if constexpr (PH == 7) {
        pg8::Gemm g{OATT, (const bf16*)(ws + WS_WO) + (size_t)l * DM * DM, MTOK, DM, DM}; pg8::StaticOrder S; S.init(MTOK, DM, G, bid);
        pg8::EpiResid E{X, modl + 5 * DM, NMOD * DM, 1.0f};
        pg8::gemm_phase<pg8::EpiResid, pg8::StaticOrder, PG8_ALIGN, PG8_SP2>(lds + RING_OFF, g, S, E);
    }
}
template <int PH>
__global__ void __launch_bounds__(NWAVES * 64, 2) phase_kernel(Params p) {
    extern __shared__ __attribute__((aligned(16))) unsigned char lds_raw[];
    run_phase<PH>(p.one_it, (LAS unsigned char*)lds_raw);
}
__global__ void __launch_bounds__(NWAVES * 64, 2) mega_fwd(Params p) {
    extern __shared__ __attribute__((aligned(16))) unsigned char lds_raw[];
    LAS unsigned char* lds = (LAS unsigned char*)lds_raw;
    for (int u = threadIdx.x; u < (LDS_BYTES - LDSCTL_OFF) / 4; u += NWAVES * 64) ((LAS unsigned*)(lds + LDSCTL_OFF))[u] = 0u;
    __syncthreads();
    (void)xcd_barrier_post((unsigned*)(p.ws + WS_CTL) + CW_BAR, (volatile LAS unsigned*)(lds + MISC_OFF) + 8);
#define GRID_BAR() do { const __attribute__((address_space(4))) Params* q_ = (const __attribute__((address_space(4))) Params*)__builtin_amdgcn_kernarg_segment_ptr(); LAUNDER_S(q_); \
        XcdBarrier b_; b_.bar = (unsigned*)(q_->ws + WS_CTL) + CW_BAR; b_.x = xb_xcc_id(); b_.st = (volatile LAS unsigned*)(lds + MISC_OFF) + 8; xcd_barrier(b_); } while (0)
#ifndef EN_MASK
#define EN_MASK 0x3FF
#endif
#define PHEN(n) (((EN_MASK) >> (n)) & 1)
    if (PHEN(8)) run_phase<8>(0, lds); GRID_BAR();
    for (int it = 0; it < 2 * DEPTH; ++it) {
        if (PHEN(0)) run_phase<0>(it, lds); GRID_BAR();
        if (PHEN(1)) run_phase<1>(it, lds); GRID_BAR();
        if (PHEN(2)) run_phase<2>(it, lds); GRID_BAR();
        if ((it & 1) == 0) {
            if (PHEN(3)) run_phase<3>(it, lds); GRID_BAR();
            if (PHEN(4)) run_phase<4>(it, lds); GRID_BAR();
            if (PHEN(5)) run_phase<5>(it, lds); GRID_BAR();
            if (PHEN(6)) run_phase<6>(it, lds); GRID_BAR();
            if (PHEN(7)) run_phase<7>(it, lds); GRID_BAR();
        }
    }
    if (PHEN(9)) run_phase<9>(0, lds);
#undef GRID_BAR
}

template <int PH> static void launch_phase(Params p, int it, int grid, hipStream_t stream) {
    static bool attr_set = false;
    if (!attr_set) { (void)hipFuncSetAttribute((const void*)phase_kernel<PH>, hipFuncAttributeMaxDynamicSharedMemorySize, LDS_BYTES); attr_set = true; }
    p.one_it = it; p.one_ph = PH;
    hipLaunchKernelGGL(phase_kernel<PH>, dim3(grid), dim3(NWAVES * 64), LDS_BYTES, stream, p);
}
extern "C" void kernel_launch(void* const* d_in, const int* in_sizes, int n_in, void* d_out, int out_size, void* d_ws, size_t ws_size, hipStream_t stream) {
    static int grid = 0;
    if (grid == 0) {
        if (n_in != 15 || in_sizes[0] != MTOK * DM || out_size != MTOK * DM || ws_size < WS_END) {
            fprintf(stderr, "kernel_launch: unexpected shapes (n_in %d, in0 %d, out %d, ws %zu, need %zu); nothing launched\n", n_in, n_in > 0 ? in_sizes[0] : -1, out_size, ws_size, (size_t)WS_END); grid = -1; return; }
        int dev = 0, cus = 0, per_cu = 0;
        if (hipGetDevice(&dev) != hipSuccess || hipDeviceGetAttribute(&cus, hipDeviceAttributeMultiprocessorCount, dev) != hipSuccess) { fprintf(stderr, "kernel_launch: device query failed\n"); grid = -1; return; }
        if (hipFuncSetAttribute((const void*)mega_fwd, hipFuncAttributeMaxDynamicSharedMemorySize, LDS_BYTES) != hipSuccess) { fprintf(stderr, "kernel_launch: hipFuncSetAttribute failed\n"); grid = -1; return; }
        if (hipOccupancyMaxActiveBlocksPerMultiprocessor(&per_cu, (const void*)mega_fwd, NWAVES * 64, LDS_BYTES) != hipSuccess || per_cu < 1)
            fprintf(stderr, "kernel_launch: note: occupancy query reports %d workgroups per CU\n", per_cu);
        (void)hipGetLastError();
        grid = cus;
    }
    if (grid < 0) return;
    if (hipMemsetAsync((char*)d_ws + WS_CTL, 0, CTL_ZERO_BYTES, stream) != hipSuccess) { fprintf(stderr, "kernel_launch: memset failed\n"); return; }
    Params p{};
    p.x = (const float*)d_in[0]; p.c = (const float*)d_in[1]; p.w_ada = (const float*)d_in[2]; p.b_ada = (const float*)d_in[3]; p.norm_g = (const float*)d_in[4];
    p.w_gu = (const float*)d_in[5]; p.w_d = (const float*)d_in[6]; p.w_in = (const float*)d_in[7]; p.w_o = (const float*)d_in[8]; p.diff_lam = (const float*)d_in[9];
    p.diff_subln = (const float*)d_in[10]; p.cmp_pe = (const float*)d_in[11]; p.cmp_w1 = (const float*)d_in[12]; p.cmp_w2 = (const float*)d_in[13]; p.final_g = (const float*)d_in[14];
    p.out = (float*)d_out; p.ws = (unsigned char*)d_ws;
#if MK_MULTI
    launch_phase<8>(p, 0, grid, stream);
    for (int it = 0; it < 2 * DEPTH; ++it) {
        launch_phase<0>(p, it, grid, stream); launch_phase<1>(p, it, grid, stream); launch_phase<2>(p, it, grid, stream);
        if ((it & 1) == 0) { launch_phase<3>(p, it, grid, stream); launch_phase<4>(p, it, grid, stream); launch_phase<5>(p, it, grid, stream); launch_phase<6>(p, it, grid, stream); launch_phase<7>(p, it, grid, stream); }
    }
    launch_phase<9>(p, 0, grid, stream);
#else
    p.one_it = -1; p.one_ph = 0;
    hipLaunchKernelGGL(mega_fwd, dim3(grid), dim3(NWAVES * 64), LDS_BYTES, stream, p);
#endif
    const hipError_t le = hipPeekAtLastError();
    if (le != hipSuccess) fprintf(stderr, "kernel_launch: launch failed: %s\n", hipGetErrorName(le));
}
```

```cpp
#include <hip/hip_runtime.h>
#include <hip/hip_bf16.h>
#include <cstdio>
#include <cstdint>
namespace pg8 {
#define PG8_LAS __attribute__((address_space(3)))
typedef unsigned short bf16_t;
typedef short bf16x8 __attribute__((ext_vector_type(8)));
typedef float f32x4 __attribute__((ext_vector_type(4)));
typedef unsigned u32x4 __attribute__((ext_vector_type(4)));
constexpr int BM = 256, BK = 64, HALF = 128, HTB = HALF * BK * 2  , STAGE_BYTES = 8 * HTB, NXCD = 8, WGM = 8;

__host__ __device__ __forceinline__ int lds_byte(int r, int c) { const int st = (r >> 4) * 2 + (c >> 5), rr = r & 15, cc = c & 31, ob = rr * 64 + cc * 2; return st * 1024 + (ob ^ (((ob >> 9) & 1) << 5)); }
__host__ __device__ __forceinline__ void stage_rc(int b, int& R, int& C) { const int st = b / 1024, sb = b % 1024, swz = sb ^ (((sb >> 9) & 1) << 5); R = (st >> 1) * 16 + swz / 64; C = (st & 1) * 32 + (swz % 64) / 2; }
__host__ __device__ __forceinline__ int perm32(int rho) { const int n = rho >> 4, i = rho & 15; return 8 * (i >> 2) + 4 * n + (i & 3); }

struct Unit { int pm, pn; };
struct Gemm { const bf16_t* A; const bf16_t* Bt; int M, N, K; };

struct StaticOrder {
    int nM, nN, nwg, G, c;
    __host__ __device__ void init(int M, int N, int G_, int c_) { nM = M / BM; nN = N / BM; nwg = nM * nN; G = G_; c = c_; }
    __host__ __device__ bool next(int i, Unit& u) const {
        const long L = (long)i * G + c; if (L >= nwg) return false;
        int wgid = (int)L; { const int q = nwg / NXCD, r = nwg % NXCD, xcd = wgid % NXCD, off = wgid / NXCD; wgid = (xcd < r ? xcd * (q + 1) : r * (q + 1) + (xcd - r) * q) + off; }
        const int nig = WGM * nN, gid = wgid / nig, fm = gid * WGM, gsz = (nM - fm) < WGM ? (nM - fm) : WGM;
        u.pm = fm + ((wgid % nig) % gsz); u.pn = (wgid % nig) / gsz; return true;
    }
    __device__ __forceinline__ void a_ready(const Unit&) const {}
    __device__ __forceinline__ void done(const Unit&) const {}
};

__device__ __forceinline__ unsigned cvt_pk_bf16(float lo, float hi) { unsigned r; asm volatile("v_cvt_pk_bf16_f32 %0, %1, %2" : "=v"(r) : "v"(lo), "v"(hi)); return r; }
typedef float f32x2 __attribute__((ext_vector_type(2)));
typedef float f32x2_t __attribute__((ext_vector_type(2))); typedef __bf16 bf16x2_t __attribute__((ext_vector_type(2)));
__device__ __forceinline__ unsigned cvtpk(float lo, float hi) { f32x2_t v = {lo, hi}; bf16x2_t b = __builtin_convertvector(v, bf16x2_t); return __builtin_bit_cast(unsigned, b); }
__host__ __device__ __forceinline__ int swap23(int r) { return (r & ~12) | ((r & 4) << 1) | ((r & 8) >> 1); }
__device__ __forceinline__ float silu_f(float g) { return g * __builtin_amdgcn_rcpf(1.0f + __builtin_amdgcn_exp2f(-1.4426950408889634f * g)); }
__device__ __forceinline__ float sigmoid_f(float g) { return __builtin_amdgcn_rcpf(1.0f + __builtin_amdgcn_exp2f(-1.4426950408889634f * g)); }

template <int K> __device__ __forceinline__ float shx(float v) {
    if constexpr (K < 32) return __builtin_bit_cast(float, __builtin_amdgcn_ds_swizzle(__builtin_bit_cast(int, v), (K << 10) | 0x1f));
    else { const unsigned u = __builtin_bit_cast(unsigned, v); auto rr = __builtin_amdgcn_permlane32_swap(u, u, false, false);
        unsigned lo; asm volatile("v_mbcnt_lo_u32_b32 %0, -1, 0" : "=v"(lo));
        return __builtin_bit_cast(float, lo >= 32u ? rr[0] : rr[1]); }
}
template <int K> __device__ __forceinline__ unsigned shxu(unsigned v) { return __builtin_bit_cast(unsigned, shx<K>(__builtin_bit_cast(float, v))); }
struct EpiSwiglu {
    static constexpr bool PERM = true, AFTER_DRAIN = false;
    bf16_t* act; int ldc;
    __device__ __forceinline__ void operator()(const f32x4 (&acc)[2][2][4][2], const Unit& u, int wr, int wc, int fr, int fq) const {
        const int row0 = u.pm * BM + wr * 64 + fr, col0 = u.pn * 128 + wc * 32 + 8 * fq;
#pragma unroll
        for (int ai = 0; ai < 2; ++ai)
#pragma unroll
            for (int m = 0; m < 4; ++m) {
                bf16_t* rowp = act + (size_t)(row0 + ai * HALF + m * 16) * ldc + col0;
                const f32x4 g0 = acc[ai][0][m][0], g1 = acc[ai][0][m][1], u0 = acc[ai][1][m][0], u1 = acc[ai][1][m][1];
                u32x4 w;
                w.x = cvtpk(silu_f(g0[0]) * u0[0], silu_f(g0[1]) * u0[1]); w.y = cvtpk(silu_f(g0[2]) * u0[2], silu_f(g0[3]) * u0[3]);
                w.z = cvtpk(silu_f(g1[0]) * u1[0], silu_f(g1[1]) * u1[1]); w.w = cvtpk(silu_f(g1[2]) * u1[2], silu_f(g1[3]) * u1[3]);
                *(u32x4*)rowp = w;
            }
    }
};
struct EpiResid {
    static constexpr bool PERM = false, AFTER_DRAIN = false;
    float* x; const float* gate; int gstride; float coef;
    __device__ __forceinline__ void operator()(const f32x4 (&acc)[2][2][4][2], const Unit& u, int wr, int wc, int fr, int fq) const {
        const int row0 = u.pm * BM + wr * 64 + fr, col0 = u.pn * BM + wc * 32 + 4 * fq;
        const float* gp = gate + (size_t)(u.pm >> 4) * gstride;
#pragma unroll
        for (int bj = 0; bj < 2; ++bj)
#pragma unroll
            for (int n = 0; n < 2; ++n) {
                const int col = col0 + bj * HALF + n * 16;
                const f32x4 gv = *(const f32x4*)(gp + col) * coef;
#pragma unroll
                for (int ai = 0; ai < 2; ++ai)
#pragma unroll
                    for (int m = 0; m < 4; ++m) {
                        float* p = x + (size_t)(row0 + ai * HALF + m * 16) * 2048 + col;
                        const f32x4 xv = *(const f32x4*)p;
                        *(f32x4*)p = xv + gv * acc[ai][bj][m][n];
                    }
            }
    }
};
struct EpiVT {
    static constexpr bool PERM = true, AFTER_DRAIN = false;
    bf16_t* vtt;
    __device__ __forceinline__ void operator()(const f32x4 (&acc)[2][2][4][2], const Unit& u, int wr, int wc, int fr, int fq) const {
#pragma unroll
        for (int ai = 0; ai < 2; ++ai)
#pragma unroll
            for (int m = 0; m < 4; ++m) {
                const int row = u.pm * BM + ai * HALF + wr * 64 + m * 16 + fr, slot = row >> 7, dt = (row >> 5) & 3, d = row & 31;
#pragma unroll
                for (int bj = 0; bj < 2; ++bj) {
                    const int tc = 32 * u.pn + 16 * bj + 4 * wc + fq, T = tc >> 2, s = (tc >> 1) & 1, h2 = tc & 1;
                    const f32x4 v0 = acc[ai][bj][m][0], v1 = acc[ai][bj][m][1];
                    u32x4 w; w.x = cvtpk(v0[0], v0[1]); w.y = cvtpk(v0[2], v0[3]); w.z = cvtpk(v1[0], v1[1]); w.w = cvtpk(v1[2], v1[3]);
                    *(u32x4*)(vtt + ((size_t)((((slot * 4 + dt) * 256 + T) * 2 + s) * 64 + h2 * 32 + d)) * 8) = w;
                }
            }
    }
};
struct EpiNat {
    static constexpr bool PERM = true, AFTER_DRAIN = false;
    bf16_t* nat; float* gates; const float* rope; float qs_d, qs_n;
    __device__ __forceinline__ void operator()(const f32x4 (&acc)[2][2][4][2], const Unit& u, int wr, int wc, int fr, int fq) const {
        asm volatile("" : "+v"(fr), "+v"(fq));
#pragma unroll
        for (int bj = 0; bj < 2; ++bj) {
            const int slot = 2 * u.pn + bj;
            if (slot >= 33) continue;
            const bool r64 = slot < 16, r128 = (slot >= 16 && slot < 24) || (slot >= 28 && slot < 32);
            const bool ktype = (slot >= 8 && slot < 16) || (slot >= 28 && slot < 32);
            const float sc = slot < 8 ? qs_d : ((slot >= 16 && slot < 24) ? qs_n : 1.0f);
#pragma unroll
            for (int ai = 0; ai < 2; ++ai)
#pragma unroll
                for (int m = 0; m < 4; ++m) {
                    const int row = u.pm * BM + ai * HALF + wr * 64 + m * 16 + fr, b = row >> 12, t = row & 4095;
                    float v[8];
#pragma unroll
                    for (int e = 0; e < 4; ++e) { v[e] = acc[ai][bj][m][0][e]; v[4 + e] = acc[ai][bj][m][1][e]; }
                    if (slot == 32) {
                        if (wc == 0 && fq < 3) {
                            float* gp = gates + (size_t)row * 24 + 8 * fq;
                            *(f32x4*)gp = (f32x4){sigmoid_f(v[0]), sigmoid_f(v[1]), sigmoid_f(v[2]), sigmoid_f(v[3])};
                            *(f32x4*)(gp + 4) = (f32x4){sigmoid_f(v[4]), sigmoid_f(v[5]), sigmoid_f(v[6]), sigmoid_f(v[7])};
                        }
                        continue;
                    }
                    const float* rp = rope + (size_t)t * 48;
                    if (r64 && (wc & 1) == 0) {
                        const f32x4 c0 = *(const f32x4*)(rp), c1 = *(const f32x4*)(rp + 4), s0 = *(const f32x4*)(rp + 8), s1 = *(const f32x4*)(rp + 12);
#pragma unroll
                        for (int e = 0; e < 8; ++e) {
                            const float pv = shx<16>(v[e]), cs = e < 4 ? c0[e & 3] : c1[e & 3], sn = e < 4 ? s0[e & 3] : s1[e & 3];
                            const float rot = fq == 0 ? v[e] * cs - pv * sn : v[e] * cs + pv * sn;
                            v[e] = fq < 2 ? rot : v[e];
                        }
                    }
                    if (r128 && wc == 0) {
                        const float* cp = rp + 16 + 8 * (fq & 1); const float* sp = rp + 32 + 8 * (fq & 1);
                        const f32x4 c0 = *(const f32x4*)(cp), c1 = *(const f32x4*)(cp + 4), s0 = *(const f32x4*)(sp), s1 = *(const f32x4*)(sp + 4);
#pragma unroll
                        for (int e = 0; e < 8; ++e) {
                            const float pv = shx<32>(v[e]), cs = e < 4 ? c0[e & 3] : c1[e & 3], sn = e < 4 ? s0[e & 3] : s1[e & 3];
                            v[e] = fq < 2 ? v[e] * cs - pv * sn : v[e] * cs + pv * sn;
                        }
                    }
                    u32x4 w; w.x = cvtpk(v[0] * sc, v[1] * sc); w.y = cvtpk(v[2] * sc, v[3] * sc); w.z = cvtpk(v[4] * sc, v[5] * sc); w.w = cvtpk(v[6] * sc, v[7] * sc);
                    const int dc = 4 * wc + fq;
                    bf16_t* base = nat + (size_t)(slot * 2 + b) * (4096 * 128);
                    if (slot >= 24 && slot < 28) *(u32x4*)(base + (size_t)t * 128 + dc * 8) = w;
                    else { const int rp2 = ktype ? swap23(t & 31) : (t & 31);
                        *(u32x4*)(base + ((size_t)(((t >> 5) * 8 + (dc >> 1)) * 64 + (dc & 1) * 32 + rp2)) * 8) = w; }
                }
        }
    }
};
template <class Epi, class Sched, bool ALIGN_EPI = false, bool SP2 = false>
__device__ __forceinline__ void gemm_phase(PG8_LAS unsigned char* lds, const Gemm g, const Sched& S, const Epi& E, int tid0_) {
    asm volatile("" : "+v"(tid0_));
    const int tid = tid0_, wid = __builtin_amdgcn_readfirstlane(tid >> 6), lane = tid & 63, wr = wid >> 2, wc = wid & 3, fr = lane & 15, fq = lane >> 4;
    const int K = g.K, nt = K / BK;
    unsigned voffA[2], voffB[2];
#pragma unroll
    for (int i = 0; i < 2; ++i) { int R, C; stage_rc(tid * 16 + i * 8192, R, C); const int Rb = Epi::PERM ? ((R & ~31) + perm32(R & 31)) : R;
        voffA[i] = (unsigned)(R * K + C) * 2u; voffB[i] = (unsigned)(Rb * K + C) * 2u; }
    const size_t kstep = (size_t)(BK * 2);
    const size_t hstep = (size_t)HALF * K * 2;
    const size_t tstep = 2 * hstep;
    const unsigned ldsw = (unsigned)wid * 1024u;
    const int aoff = lds_byte(wr * 64 + fr, fq * 8), boff = lds_byte(wc * 32 + fr, fq * 8);
#define PG8_SA(b, h) (((b) * 2 + (h)) * HTB)
#define PG8_SB(b, h) ((4 + (b) * 2 + (h)) * HTB)
#define PG8_STAGE(bufoff, gbase, voff) do { _Pragma("unroll") for (int _i = 0; _i < 2; ++_i) \
        __builtin_amdgcn_global_load_lds((const unsigned*)((const char*)(gbase) + (voff)[_i]), (PG8_LAS unsigned*)(lds + (bufoff) + ldsw + _i * 8192), 16, 0, 0); } while (0)
#define PG8_LDA(dst, b, h) do { _Pragma("unroll") for (int m = 0; m < 4; ++m) _Pragma("unroll") for (int k = 0; k < 2; ++k) dst[m][k] = *(const PG8_LAS bf16x8*)(lds + PG8_SA(b, h) + aoff + m * 2048 + k * 1024); } while (0)
#define PG8_LDB(dst, b, h) do { _Pragma("unroll") for (int n = 0; n < 2; ++n) _Pragma("unroll") for (int k = 0; k < 2; ++k) dst[n][k] = *(const PG8_LAS bf16x8*)(lds + PG8_SB(b, h) + boff + n * 2048 + k * 1024); } while (0)
#define PG8_MMA(ai, bj, At, Bt) do { __builtin_amdgcn_s_setprio(1); _Pragma("unroll") for (int m = 0; m < 4; ++m) _Pragma("unroll") for (int n = 0; n < 2; ++n) _Pragma("unroll") for (int k = 0; k < 2; ++k) \
        acc[ai][bj][m][n] = __builtin_amdgcn_mfma_f32_16x16x32_bf16(Bt[n][k], At[m][k], acc[ai][bj][m][n], 0, 0, 0); __builtin_amdgcn_s_setprio(0); } while (0)
#define PG8_WAIT_V(n) asm volatile("s_waitcnt vmcnt(" #n ")" ::: "memory")
#define PG8_WAIT_L(n) asm volatile("s_waitcnt lgkmcnt(" #n ")" ::: "memory")
#define PG8_BAR __builtin_amdgcn_s_barrier()
#define PG8_SCHED __builtin_amdgcn_sched_barrier(0)
    Unit cur, nxt; int ui = 0;
    if (!S.next(0, cur)) return;
    f32x4 acc[2][2][4][2];
#pragma unroll
    for (int a = 0; a < 2; ++a)
#pragma unroll
        for (int b = 0; b < 2; ++b)
#pragma unroll
            for (int m = 0; m < 4; ++m)
#pragma unroll
                for (int n = 0; n < 2; ++n) acc[a][b][m][n] = (f32x4){0.f, 0.f, 0.f, 0.f};
    bf16x8 At[4][2], B0[2][2], B1[2][2];
    const char* cA = (const char*)g.A + (size_t)cur.pm * tstep; const char* cB = (const char*)g.Bt + (size_t)cur.pn * tstep;
    S.a_ready(cur);
    if constexpr (SP2) {
        PG8_STAGE(PG8_SB(0, 0), cB, voffB); PG8_STAGE(PG8_SB(0, 1), cB + hstep, voffB); PG8_STAGE(PG8_SA(0, 0), cA, voffA); PG8_STAGE(PG8_SA(0, 1), cA + hstep, voffA);
        if (wr == 1) PG8_BAR;
        PG8_WAIT_V(2); PG8_BAR;
        PG8_STAGE(PG8_SB(1, 0), cB + kstep, voffB); PG8_STAGE(PG8_SA(1, 0), cA + kstep, voffA); PG8_STAGE(PG8_SB(1, 1), cB + hstep + kstep, voffB);
        PG8_WAIT_V(6); PG8_BAR;
    } else {
        PG8_STAGE(PG8_SB(0, 0), cB, voffB); PG8_STAGE(PG8_SA(0, 0), cA, voffA); PG8_STAGE(PG8_SB(0, 1), cB + hstep, voffB); PG8_STAGE(PG8_SA(0, 1), cA + hstep, voffA);
        if (wr == 1) PG8_BAR;
        PG8_WAIT_V(4); PG8_BAR;
        PG8_STAGE(PG8_SB(1, 0), cB + kstep, voffB); PG8_STAGE(PG8_SA(1, 0), cA + kstep, voffA); PG8_STAGE(PG8_SB(1, 1), cB + hstep + kstep, voffB);
        PG8_WAIT_V(6); PG8_BAR;
    }
    for (;;) {
        const bool has_next = S.next(ui + 1, nxt);
        const char* nA = has_next ? (const char*)g.A + (size_t)nxt.pm * tstep : cA; const char* nB = has_next ? (const char*)g.Bt + (size_t)nxt.pn * tstep : cB;
        for (int t = 0; t < nt; t += 2) {
            const bool last = (t == nt - 2);
            const char* a1 = cA + (size_t)(t + 1) * kstep;
            const char* a2 = last ? nA : cA + (size_t)(t + 2) * kstep; const char* b2 = last ? nB : cB + (size_t)(t + 2) * kstep;
            const char* a3 = a2 + kstep; const char* b3 = b2 + kstep;
            if (last && has_next) S.a_ready(nxt);
            if constexpr (SP2) {
            PG8_LDB(B0, 0, 0); PG8_LDB(B1, 0, 1); PG8_SCHED; PG8_LDA(At, 0, 0); PG8_STAGE(PG8_SA(1, 1), a1 + hstep, voffA);
            PG8_WAIT_V(8); PG8_WAIT_L(0); PG8_BAR; PG8_MMA(0, 0, At, B0); PG8_MMA(0, 1, At, B1); PG8_BAR; PG8_SCHED;
            PG8_LDA(At, 0, 1); PG8_STAGE(PG8_SB(0, 0), b2, voffB); PG8_STAGE(PG8_SB(0, 1), b2 + hstep, voffB); PG8_STAGE(PG8_SA(0, 0), a2, voffA);
            PG8_WAIT_V(8); PG8_WAIT_L(0); PG8_BAR; PG8_MMA(1, 0, At, B0); PG8_MMA(1, 1, At, B1); PG8_BAR; PG8_SCHED;
            PG8_LDB(B0, 1, 0); PG8_LDB(B1, 1, 1); PG8_SCHED; PG8_LDA(At, 1, 0); PG8_STAGE(PG8_SA(0, 1), a2 + hstep, voffA);
            PG8_WAIT_V(8); PG8_WAIT_L(0); PG8_BAR; PG8_MMA(0, 0, At, B0); PG8_MMA(0, 1, At, B1); PG8_BAR; PG8_SCHED;
            PG8_LDA(At, 1, 1); PG8_STAGE(PG8_SB(1, 0), b3, voffB); PG8_STAGE(PG8_SB(1, 1), b3 + hstep, voffB); PG8_STAGE(PG8_SA(1, 0), a3, voffA);
            PG8_WAIT_V(8); PG8_WAIT_L(0); PG8_BAR; PG8_MMA(1, 0, At, B0); PG8_MMA(1, 1, At, B1); PG8_BAR; PG8_SCHED;
            } else {
            PG8_LDB(B0, 0, 0); PG8_SCHED; PG8_LDA(At, 0, 0); PG8_STAGE(PG8_SA(1, 1), a1 + hstep, voffA);
            PG8_WAIT_L(8); PG8_BAR; PG8_WAIT_L(0); PG8_MMA(0, 0, At, B0); PG8_BAR; PG8_SCHED;
            PG8_LDB(B1, 0, 1); PG8_STAGE(PG8_SB(0, 0), b2, voffB);
            PG8_BAR; PG8_WAIT_L(0); PG8_MMA(0, 1, At, B1); PG8_BAR;
            PG8_LDA(At, 0, 1); PG8_STAGE(PG8_SA(0, 0), a2, voffA);
            PG8_BAR; PG8_WAIT_L(0); PG8_MMA(1, 0, At, B0); PG8_BAR; PG8_SCHED;
            PG8_STAGE(PG8_SB(0, 1), b2 + hstep, voffB);
            PG8_WAIT_V(6); PG8_BAR; PG8_MMA(1, 1, At, B1); PG8_BAR;
            PG8_LDB(B0, 1, 0); PG8_SCHED; PG8_LDA(At, 1, 0); PG8_STAGE(PG8_SA(0, 1), a2 + hstep, voffA);
            PG8_WAIT_L(8); PG8_BAR; PG8_WAIT_L(0); PG8_MMA(0, 0, At, B0); PG8_BAR; PG8_SCHED;
            PG8_LDB(B1, 1, 1); PG8_STAGE(PG8_SB(1, 0), b3, voffB);
            PG8_BAR; PG8_WAIT_L(0); PG8_MMA(0, 1, At, B1); PG8_BAR;
            PG8_LDA(At, 1, 1); PG8_STAGE(PG8_SA(1, 0), a3, voffA);
            PG8_BAR; PG8_WAIT_L(0); PG8_MMA(1, 0, At, B0); PG8_BAR; PG8_SCHED;
            PG8_STAGE(PG8_SB(1, 1), b3 + hstep, voffB);
            PG8_WAIT_V(6); PG8_BAR; PG8_MMA(1, 1, At, B1); PG8_BAR;
            }
        }
        if constexpr (ALIGN_EPI) { if (wr == 0) PG8_BAR; }
        if constexpr (!Epi::AFTER_DRAIN) { E(acc, cur, wr, wc, fr, fq); S.done(cur); }
        if (!has_next) break;
#pragma unroll
        for (int a = 0; a < 2; ++a)
#pragma unroll
            for (int b = 0; b < 2; ++b)
#pragma unroll
                for (int m = 0; m < 4; ++m)
#pragma unroll
                    for (int n = 0; n < 2; ++n) acc[a][b][m][n] = (f32x4){0.f, 0.f, 0.f, 0.f};
        cur = nxt; cA = nA; cB = nB; ++ui;
        if constexpr (ALIGN_EPI) { if (wr == 1) PG8_BAR; }
    }
    PG8_WAIT_V(0);
    if constexpr (!ALIGN_EPI) { if (wr == 0) PG8_BAR; }
    PG8_BAR;
    if constexpr (Epi::AFTER_DRAIN) { E.fused(acc, cur, wr, wc, fr, fq, lds, wid, lane); S.done(cur); }
#undef PG8_SA
#undef PG8_SB
#undef PG8_STAGE
#undef PG8_LDA
#undef PG8_LDB
#undef PG8_MMA
#undef PG8_WAIT_V
#undef PG8_WAIT_L
#undef PG8_BAR
#undef PG8_SCHED
}
}
#ifndef PG8_SP2
#define PG8_SP2 true
#endif
#ifndef PG8_ALIGN
#define PG8_ALIGN true
#endif
constexpr int NWAVES = 8;
constexpr int BATCH = 2, SEQ = 4096, DM = 2048, MTOK = BATCH * SEQ, DEPTH = 4, DFF = 5632, NGU = 2 * DFF, INC = 5656;
constexpr int NATN = 4352, VTN = 1536, NMOD = 9;
constexpr float RMS_EPS = 1e-6f;
constexpr float LOG2E = 1.4426950408889634f;
#ifndef ATTN_V2
#define ATTN_V2 1
#endif
#ifndef MK_MULTI
#define MK_MULTI 0
#endif
constexpr size_t al256(size_t x) { return (x + 255) & ~(size_t)255; }
constexpr size_t WS_CTL = 0, CTL_ZERO_BYTES = 1u << 20;
constexpr size_t WS_MOD = CTL_ZERO_BYTES;
constexpr size_t WS_ROPE = al256(WS_MOD + (size_t)DEPTH * BATCH * NMOD * DM * 4);
constexpr size_t WS_BIAS1 = al256(WS_ROPE + (size_t)SEQ * 48 * 4);
constexpr size_t WS_LAM = al256(WS_BIAS1 + (size_t)DEPTH * 2 * 256 * 4);
constexpr size_t WS_WGU = al256(WS_LAM + 256);
constexpr size_t WS_WD = al256(WS_WGU + (size_t)DEPTH * 2 * NGU * DM * 2);
constexpr size_t WS_WNAT = al256(WS_WD + (size_t)DEPTH * 2 * DM * DFF * 2);
constexpr size_t WS_WV = al256(WS_WNAT + (size_t)DEPTH * NATN * DM * 2);
constexpr size_t WS_WO = al256(WS_WV + (size_t)DEPTH * VTN * DM * 2);
constexpr size_t WS_W1T = al256(WS_WO + (size_t)DEPTH * DM * DM * 2);
constexpr size_t WS_W2T = al256(WS_W1T + (size_t)DEPTH * 2 * 256 * 4096 * 2);
constexpr size_t WS_H = al256(WS_W2T + (size_t)DEPTH * 2 * 128 * 256 * 2);
constexpr size_t WS_ACT = al256(WS_H + (size_t)MTOK * DM * 2);
constexpr size_t WS_NAT = al256(WS_ACT + (size_t)MTOK * DFF * 2);
constexpr size_t WS_VTT = al256(WS_NAT + (size_t)32 * MTOK * 128 * 2);
constexpr size_t WS_KC = al256(WS_VTT + (size_t)VTN * MTOK * 2);
constexpr size_t WS_VCT = al256(WS_KC + (size_t)4 * 256 * 128 * 2);
constexpr size_t WS_GATES = al256(WS_VCT + (size_t)4 * 256 * 128 * 2);
constexpr size_t WS_OATT = al256(WS_GATES + (size_t)MTOK * 24 * 4);
constexpr size_t WS_SCR = al256(WS_OATT + (size_t)MTOK * DM * 2);
constexpr size_t WS_END = al256(WS_SCR + (size_t)512 * 8 * 4096 * 4);
constexpr int CW_BAR = 4096;
constexpr int RING_OFF = 0, RING_BYTES = 131072;
constexpr int LDSCTL_OFF = RING_BYTES, MISC_OFF = LDSCTL_OFF + 320;
constexpr int LDS_BYTES = 155648;

#define GAS __attribute__((address_space(1)))
#define LAS __attribute__((address_space(3)))
typedef unsigned short bf16;
typedef unsigned v4u __attribute__((ext_vector_type(4)));
typedef unsigned v2u __attribute__((ext_vector_type(2)));
typedef float f32x4 __attribute__((ext_vector_type(4)));
typedef float f32x16 __attribute__((ext_vector_type(16)));
typedef short bf16x8 __attribute__((ext_vector_type(8)));
typedef GAS unsigned gu32;
#define RLX_AGENT __ATOMIC_RELAXED, __HIP_MEMORY_SCOPE_AGENT
#define LDS_WAIT() asm volatile("s_waitcnt lgkmcnt(0)" ::: "memory")
using pg8::cvtpk; using pg8::swap23; using pg8::shx; using pg8::shxu;
__device__ __forceinline__ unsigned f2bf(float f) { unsigned u = __builtin_bit_cast(unsigned, f); return (u + 0x7fffu + ((u >> 16) & 1u)) >> 16; }
__device__ __forceinline__ unsigned pk2(float lo, float hi) { return f2bf(lo) | (f2bf(hi) << 16); }
__device__ __forceinline__ float ex2(float x) { return __builtin_amdgcn_exp2f(x); }
#define XB_TMO      128
#define XB_XCNT(j)  (256  + 64 * (j))
#define XB_XSUB(j)  (1280 + 64 * (j))
#define XB_XGEN(j)  (2304 + 64 * (j))
#define XB_TOP      3328
#define XB_TOPGEN   3392
#define XCD_BAR_WORDS 3456
#define XB_SPIN_CAP (1u << 18)

__device__ __forceinline__ unsigned xb_ld(unsigned* p)              { return __hip_atomic_load(p, __ATOMIC_RELAXED, __HIP_MEMORY_SCOPE_AGENT); }
__device__ __forceinline__ unsigned xb_add(unsigned* p, unsigned v) { return __hip_atomic_fetch_add(p, v, __ATOMIC_RELAXED, __HIP_MEMORY_SCOPE_AGENT); }
__device__ __forceinline__ unsigned xb_xcc_id() { return (unsigned)__builtin_amdgcn_s_getreg((3 << 11) | 20) & 0xFu; }
#define XB_SPIN(cond, bar) do { unsigned _sp = 0; while (cond) { __builtin_amdgcn_s_sleep(1); \
    if ((++_sp & 255u) == 0u) { if (xb_ld(&(bar)[XB_TMO])) break; if (_sp > XB_SPIN_CAP) { atomicAdd(&(bar)[XB_TMO], 1u); break; } } } } while (0)

struct XcdBarrier {
    unsigned* bar; unsigned x; bool t0;
    volatile LAS unsigned* st;
};

__device__ __forceinline__ XcdBarrier xcd_barrier_post(unsigned* bar, volatile LAS unsigned* st) {
    XcdBarrier b; b.bar = bar; b.x = xb_xcc_id(); b.st = st; b.t0 = (threadIdx.x == 0);
    if (threadIdx.x == 0) (void)xb_add(&bar[XB_XCNT(b.x)], 1u);
    return b;
}
__device__ __forceinline__ void xcd_barrier_complete(unsigned* bar, unsigned x, unsigned& nloc, unsigned& nx) {
    const unsigned G = gridDim.x * gridDim.y * gridDim.z;
    unsigned sum, cnt, mine, sp = 0u;
    for (;;) {
        sum = 0u; cnt = 0u; mine = 0u;
#pragma unroll
        for (unsigned j = 0; j < 16; ++j) { const unsigned c = xb_ld(&bar[XB_XCNT(j)]); sum += c; cnt += (c > 0u) ? 1u : 0u; mine = (j == x) ? c : mine; }
        if (sum == G) break;
        __builtin_amdgcn_s_sleep(1);
        if ((++sp & 255u) == 0u) { if (xb_ld(&bar[XB_TMO])) break; if (sp > XB_SPIN_CAP) { atomicAdd(&bar[XB_TMO], 1u); break; } }
    }
    nloc = mine > 0u ? mine : 1u; nx = cnt > 0u ? cnt : 1u;
}

__device__ __forceinline__ void xcd_barrier(const XcdBarrier& b) {
    asm volatile("s_waitcnt vmcnt(0)" ::: "memory");
    __syncthreads();
    if (b.t0) {
        unsigned* bar = b.bar;
        __builtin_amdgcn_s_waitcnt(0);
        unsigned nloc = b.st[0], nx = b.st[1];
        if (nloc == 0u) { xcd_barrier_complete(bar, b.x, nloc, nx); b.st[0] = nloc; b.st[1] = nx; }
        const unsigned old = xb_add(&bar[XB_XSUB(b.x)], 1u);
        const unsigned gen = old / nloc;
        if (old + 1u == (gen + 1u) * nloc) {
            __builtin_amdgcn_fence(__ATOMIC_RELEASE, "agent");
            asm volatile("s_waitcnt vmcnt(0)" ::: "memory");
            const unsigned og = xb_add(&bar[XB_TOP], 1u);
            const unsigned tg = og / nx;
            if (og + 1u == (tg + 1u) * nx) xb_add(&bar[XB_TOPGEN], 1u);
            else XB_SPIN(xb_ld(&bar[XB_TOPGEN]) == tg, bar);
            __builtin_amdgcn_fence(__ATOMIC_ACQUIRE, "agent");
            xb_add(&bar[XB_XGEN(b.x)], 1u);
            asm volatile("s_waitcnt vmcnt(0)" ::: "memory");
        } else {
            XB_SPIN(xb_ld(&bar[XB_XGEN(b.x)]) == gen, bar);
            __builtin_amdgcn_fence(__ATOMIC_ACQUIRE, "agent");
            asm volatile("s_waitcnt vmcnt(0)" ::: "memory");
        }
    }
    __syncthreads();
}
struct Params {
    const float *x, *c, *w_ada, *b_ada, *norm_g, *w_gu, *w_d, *w_in, *w_o, *diff_lam, *diff_subln, *cmp_pe, *cmp_w1, *cmp_w2, *final_g;
    float* out; unsigned char* ws; int one_it, one_ph;
};
__device__ __forceinline__ float wave_sum(float v) {
    v += shx<1>(v); v += shx<2>(v); v += shx<4>(v); v += shx<8>(v); v += shx<16>(v); v += shx<32>(v);
    return v;
}
__device__ __forceinline__ void transpose_item(const float* W, size_t ldw, int K, int k0, int n0, bf16* WT, int dst_row, LAS float* scr, int lane) {
#pragma unroll 8
    for (int i = 0; i < 32; ++i) { const int kk = 2 * i + (lane >> 5); scr[kk * 33 + (lane & 31)] = W[(size_t)(k0 + kk) * ldw + n0 + (lane & 31)]; }
    LDS_WAIT(); asm volatile("" ::: "memory");
    const int c = lane & 7;
#pragma unroll
    for (int j = 0; j < 4; ++j) { const int n = (lane >> 3) + 8 * j; const LAS float* s = scr + (8 * c) * 33 + n;
        v4u o; o.x = pk2(s[0 * 33], s[1 * 33]); o.y = pk2(s[2 * 33], s[3 * 33]); o.z = pk2(s[4 * 33], s[5 * 33]); o.w = pk2(s[6 * 33], s[7 * 33]);
        *(v4u*)(WT + (size_t)(dst_row + n) * K + k0 + 8 * c) = o; }
    LDS_WAIT(); asm volatile("" ::: "memory");
}
__device__ __forceinline__ void transpose_cols(const float* W, size_t ldw, int K, int ncols, int map, bf16* WT, int dst0, LAS float* scr, int gw, int NGW, int lane) {
    const int nblk = ncols / 32, nitems = (K / 64) * nblk;
    for (int it = gw; it < nitems; it += NGW) {
        const int kb = it / nblk, nb = it % nblk, n0 = nb * 32;
        int dr = dst0 + n0;
        if (map == 1) { const int n = n0 < DFF ? n0 : n0 - DFF; dr = 256 * (n >> 7) + (n & 127) + (n0 < DFF ? 0 : 128); }
        transpose_item(W, ldw, K, kb * 64, n0, WT, dr, scr, lane);
    }
}
template <int NB, bool SILU>
__device__ __forceinline__ void gemv_unit(const float* W, size_t ldw, int K, const float* vec, size_t vstride, float* out, size_t ostride, const float* bias, LAS unsigned char* lds, int tid, int wave, int lane) {
    LAS float* vs = (LAS float*)lds;
    LAS float* part = (LAS float*)(lds + 32768);
    for (int i = tid; i < NB * K; i += NWAVES * 64) { const int b = i / K, k = i % K; float v = vec[(size_t)b * vstride + k]; if (SILU) v = v / (1.0f + __expf(-v)); vs[i] = v; }
    __syncthreads();
    f32x4 acc[NB];
#pragma unroll
    for (int b = 0; b < NB; ++b) acc[b] = (f32x4){0.f, 0.f, 0.f, 0.f};
    const int kc = K / NWAVES, kbeg = wave * kc;
    const float* wp = W + (size_t)kbeg * ldw + 4 * lane;
#pragma unroll 8
    for (int k = 0; k < kc; ++k) { const f32x4 wv = *(const f32x4*)(wp + (size_t)k * ldw);
#pragma unroll
        for (int b = 0; b < NB; ++b) acc[b] += vs[b * K + kbeg + k] * wv; }
#pragma unroll
    for (int b = 0; b < NB; ++b) *(LAS f32x4*)(part + (wave * NB + b) * 256 + 4 * lane) = acc[b];
    __syncthreads();
    if (tid < NB * 256) { const int b = tid >> 8, n = tid & 255; float s = bias ? bias[n] : 0.f;
#pragma unroll
        for (int w = 0; w < NWAVES; ++w) s += part[(w * NB + b) * 256 + n];
        out[(size_t)b * ostride + n] = s; }
    __syncthreads();
}
__device__ __forceinline__ void prologue(const Params& p, LAS unsigned char* lds, int bid, int G, int tid, int wave, int lane) {
    unsigned char* ws = p.ws;
    const int gw = bid * NWAVES + wave, NGW = G * NWAVES;
    for (int u = bid; u < 288 + 8; u += G) {
        if (u < 288) { const int l = u / 72, n0 = (u % 72) * 256;
            gemv_unit<2, true>(p.w_ada + (size_t)l * DM * (NMOD * DM) + n0, (size_t)NMOD * DM, DM, p.c, DM, (float*)(ws + WS_MOD) + (size_t)l * 2 * NMOD * DM + n0, (size_t)NMOD * DM, p.b_ada + (size_t)l * NMOD * DM + n0, lds, tid, wave, lane);
        } else { const int lj = u - 288;
            gemv_unit<1, false>(p.cmp_w1 + (size_t)lj * 4096 * 256, 256, 4096, p.cmp_pe + (size_t)lj * 4096, 0, (float*)(ws + WS_BIAS1) + lj * 256, 0, nullptr, lds, tid, wave, lane);
        }
    }
    { const f32x4* s = (const f32x4*)p.x; f32x4* d = (f32x4*)p.out; const size_t n4 = (size_t)MTOK * DM / 4;
      for (size_t i = (size_t)bid * (NWAVES * 64) + tid; i < n4; i += (size_t)G * (NWAVES * 64)) d[i] = s[i]; }
    { float* rp = (float*)(ws + WS_ROPE);
      for (int i = bid * (NWAVES * 64) + tid; i < SEQ * 24; i += G * (NWAVES * 64)) { const int t = i / 24, k = i % 24;
          const int half = k < 8 ? 8 : 16, ii = k < 8 ? k : k - 8;
          const float inv = expf((-13.122363377404328f * (float)ii) / (float)half), ang = (float)t * inv;
          const float cs = cosf(ang), sn = sinf(ang);
          if (k < 8) { rp[t * 48 + ii] = cs; rp[t * 48 + 8 + ii] = sn; } else { rp[t * 48 + 16 + ii] = cs; rp[t * 48 + 32 + ii] = sn; } } }
    if (bid == 0 && tid < DEPTH) { const float* lf = p.diff_lam + tid * 4 * 64; float s01 = 0.f, s23 = 0.f;
        for (int i = 0; i < 64; ++i) { s01 += lf[i] * lf[64 + i]; s23 += lf[128 + i] * lf[192 + i]; }
        const float li = 0.8f - 0.6f * expf(-0.3f * (float)tid);
        float* o = (float*)(ws + WS_LAM) + tid * 2; o[0] = expf(s01) - expf(s23) + li; o[1] = 1.0f - li; }
    for (int i = bid * (NWAVES * 64) + tid; i < DEPTH * 24 * DM; i += G * (NWAVES * 64)) { const int l = i / (24 * DM), r = i % (24 * DM), cidx = r / DM, k = r % DM;
        ((bf16*)(ws + WS_WNAT))[((size_t)l * NATN + 4096 + cidx) * DM + k] = (bf16)f2bf(p.w_in[((size_t)l * DM + k) * INC + 5632 + cidx]); }
    LAS float* scr = (LAS float*)(lds + wave * 16384);
    for (int l = 0; l < DEPTH; ++l) {
        for (int f = 0; f < 2; ++f) {
            transpose_cols(p.w_gu + (size_t)(l * 2 + f) * DM * NGU, NGU, DM, NGU, 1, (bf16*)(ws + WS_WGU) + (size_t)(l * 2 + f) * NGU * DM, 0, scr, gw, NGW, lane);
            transpose_cols(p.w_d + (size_t)(l * 2 + f) * DFF * DM, DM, DFF, DM, 0, (bf16*)(ws + WS_WD) + (size_t)(l * 2 + f) * DM * DFF, 0, scr, gw, NGW, lane);
            transpose_cols(p.cmp_w1 + (size_t)(l * 2 + f) * 4096 * 256, 256, 4096, 256, 0, (bf16*)(ws + WS_W1T) + (size_t)(l * 2 + f) * 256 * 4096, 0, scr, gw, NGW, lane);
            transpose_cols(p.cmp_w2 + (size_t)(l * 2 + f) * 256 * 128, 128, 256, 128, 0, (bf16*)(ws + WS_W2T) + (size_t)(l * 2 + f) * 128 * 256, 0, scr, gw, NGW, lane);
        }
        const float* wi = p.w_in + (size_t)l * DM * INC; bf16* wn = (bf16*)(ws + WS_WNAT) + (size_t)l * NATN * DM; bf16* wv = (bf16*)(ws + WS_WV) + (size_t)l * VTN * DM;
        transpose_cols(wi + 0, INC, DM, 1024, 0, wn, 0, scr, gw, NGW, lane);
        transpose_cols(wi + 1024, INC, DM, 1024, 0, wn, 1024, scr, gw, NGW, lane);
        transpose_cols(wi + 2048, INC, DM, 1024, 0, wv, 0, scr, gw, NGW, lane);
        transpose_cols(wi + 3072, INC, DM, 1024, 0, wn, 2048, scr, gw, NGW, lane);
        transpose_cols(wi + 4096, INC, DM, 256, 0, wn, 3072, scr, gw, NGW, lane);
        transpose_cols(wi + 4352, INC, DM, 256, 0, wn, 3328, scr, gw, NGW, lane);
        transpose_cols(wi + 4608, INC, DM, 256, 0, wn, 3584, scr, gw, NGW, lane);
        transpose_cols(wi + 4864, INC, DM, 256, 0, wv, 1024, scr, gw, NGW, lane);
        transpose_cols(wi + 5120, INC, DM, 256, 0, wn, 3840, scr, gw, NGW, lane);
        transpose_cols(wi + 5376, INC, DM, 256, 0, wv, 1280, scr, gw, NGW, lane);
        transpose_cols(p.w_o + (size_t)l * DM * DM, DM, DM, DM, 0, (bf16*)(ws + WS_WO) + (size_t)l * DM * DM, 0, scr, gw, NGW, lane);
    }
}
__device__ __forceinline__ void norm_phase(const float* x, const float* g, const float* shift, const float* scale, size_t bstride, bf16* h, int gw, int NGW, int lane) {
    for (int m = gw; m < MTOK; m += NGW) {
        const int b = m >> 12;
        const f32x4* xr = (const f32x4*)(x + (size_t)m * DM) + lane;
        f32x4 v[8]; float s = 0.f;
#pragma unroll
        for (int j = 0; j < 8; ++j) { v[j] = xr[64 * j]; s += (v[j].x * v[j].x + v[j].y * v[j].y) + (v[j].z * v[j].z + v[j].w * v[j].w); }
        const float rstd = rsqrtf(wave_sum(s) * (1.f / DM) + RMS_EPS);
        const f32x4* gp = (const f32x4*)g + lane; const f32x4* sh = (const f32x4*)(shift + (size_t)b * bstride) + lane; const f32x4* sc = (const f32x4*)(scale + (size_t)b * bstride) + lane;
        v2u* o = (v2u*)(h + (size_t)m * DM) + lane;
#pragma unroll
        for (int j = 0; j < 8; ++j) { const f32x4 y = (v[j] * rstd) * gp[64 * j] * (sc[64 * j] + 1.0f) + sh[64 * j];
            v2u w; w.x = cvtpk(y.x, y.y); w.y = cvtpk(y.z, y.w); o[64 * j] = w; }
    }
}
__device__ __forceinline__ void final_norm_phase(float* x, const float* g, int gw, int NGW, int lane) {
    for (int m = gw; m < MTOK; m += NGW) {
        f32x4* xr = (f32x4*)(x + (size_t)m * DM) + lane;
        f32x4 v[8]; float s = 0.f;
#pragma unroll
        for (int j = 0; j < 8; ++j) { v[j] = xr[64 * j]; s += (v[j].x * v[j].x + v[j].y * v[j].y) + (v[j].z * v[j].z + v[j].w * v[j].w); }
        const float rstd = rsqrtf(wave_sum(s) * (1.f / DM) + RMS_EPS);
        const f32x4* gp = (const f32x4*)g + lane;
#pragma unroll
        for (int j = 0; j < 8; ++j) xr[64 * j] = (v[j] * rstd) * gp[64 * j];
    }
}
#define MFMA16(a, b, c) __builtin_amdgcn_mfma_f32_16x16x32_bf16((a), (b), (c), 0, 0, 0)
#define MFMA32(a, b, c) __builtin_amdgcn_mfma_f32_32x32x16_bf16((a), (b), (c), 0, 0, 0)
__device__ __forceinline__ bf16x8 ldg8(const bf16* p) { return *(const bf16x8*)p; }
__device__ __forceinline__ void compress_unit(const Params& p, int layer, int u, LAS unsigned char* lds, int tid, int wave, int lane) {
    unsigned char* ws = p.ws;
    const int jj = u >> 6, b = (u >> 5) & 1, g = (u >> 4) & 1, n0 = (u & 15) * 16;
    const bf16* A = (const bf16*)(ws + WS_NAT) + (size_t)((24 + 2 * jj + g) * 2 + b) * (4096 * 128);
    const bf16* W1 = (const bf16*)(ws + WS_W1T) + (size_t)(layer * 2 + jj) * 256 * 4096;
    const bf16* W2 = (const bf16*)(ws + WS_W2T) + (size_t)(layer * 2 + jj) * 128 * 256;
    const float* b1 = (const float*)(ws + WS_BIAS1) + (layer * 2 + jj) * 256;
    const int r16 = lane & 15, kq = lane >> 4;
    int nr = n0 + r16; if (nr > 254) nr = 254;
    const bf16* ap = A + (size_t)nr * 2048 + 8 * kq;
    const bf16* bp0 = W1 + (size_t)(32 * wave + r16) * 4096 + 8 * kq; const bf16* bp1 = bp0 + 16 * 4096;
    f32x4 acc0 = {0.f, 0.f, 0.f, 0.f}, acc1 = {0.f, 0.f, 0.f, 0.f};
#pragma unroll 8
    for (int ks = 0; ks < 128; ++ks) { const bf16x8 a = ldg8(ap + 32 * ks), w0 = ldg8(bp0 + 32 * ks), w1 = ldg8(bp1 + 32 * ks); acc0 = MFMA16(a, w0, acc0); acc1 = MFMA16(a, w1, acc1); }
    LAS bf16* Hs = (LAS bf16*)lds;
#pragma unroll
    for (int i = 0; i < 4; ++i) { const int row = 4 * kq + i, col = 32 * wave + r16;
        Hs[row * 264 + col] = (bf16)f2bf(pg8::silu_f(acc0[i] + b1[col])); Hs[row * 264 + col + 16] = (bf16)f2bf(pg8::silu_f(acc1[i] + b1[col + 16])); }
    __syncthreads();
    f32x4 acc = {0.f, 0.f, 0.f, 0.f};
    const bf16* wp = W2 + (size_t)(16 * wave + r16) * 256 + 8 * kq;
#pragma unroll
    for (int ks = 0; ks < 8; ++ks) { const bf16x8 a = *(const LAS bf16x8*)(Hs + r16 * 264 + 32 * ks + 8 * kq); acc = MFMA16(a, ldg8(wp + 32 * ks), acc); }
    const int dcol = 16 * wave + r16;
#pragma unroll
    for (int i = 0; i < 4; ++i) { const int n = n0 + 4 * kq + i; const bf16 val = (bf16)(n <= 254 ? f2bf(acc[i]) : 0u);
        if (jj == 0) ((bf16*)(ws + WS_KC))[(size_t)(b * 2 + g) * (256 * 128) + ((size_t)((((n >> 5) * 8 + (dcol >> 4)) * 64) + (((dcol >> 3) & 1) * 32 + swap23(n & 31)))) * 8 + (dcol & 7)] = val;
        else ((bf16*)(ws + WS_VCT))[(size_t)(b * 2 + g) * (256 * 128) + ((size_t)(((((dcol >> 5) * 8 + (n >> 5)) * 2 + ((n >> 4) & 1)) * 64) + ((n >> 3) & 1) * 32 + (dcol & 31))) * 8 + (n & 7)] = val; }
    __syncthreads();
}
__device__ __forceinline__ unsigned mask_le(int kbase, int lim) { unsigned r = 0;
#pragma unroll
    for (int i = 0; i < 16; ++i) r |= (unsigned)((kbase + (i & 7) + 16 * (i >> 3)) <= lim) << i;
    return r; }
__device__ __forceinline__ unsigned mask_ge(int kbase, int lim) { unsigned r = 0;
#pragma unroll
    for (int i = 0; i < 16; ++i) r |= (unsigned)((kbase + (i & 7) + 16 * (i >> 3)) >= lim) << i;
    return r; }
template <int NSTEP>
__device__ __forceinline__ f32x16 qk_tile(const bf16* kp, const bf16x8 (&qf)[NSTEP]) {
    f32x16 s;
#pragma unroll
    for (int i = 0; i < 16; ++i) s[i] = 0.f;
#pragma unroll
    for (int st = 0; st < NSTEP; ++st) s = MFMA32(ldg8(kp + st * 512), qf[st], s);
    return s;
}
__device__ __forceinline__ void stat_update(float& m, float& l, const f32x16& s, unsigned allow) {
    float tm = -1e30f;
#pragma unroll
    for (int i = 0; i < 16; ++i) tm = fmaxf(tm, ((allow >> i) & 1u) ? s[i] : -1e30f);
    tm = fmaxf(tm, shx<32>(tm));
    const float mn = fmaxf(m, tm);
    float a = 0.f;
#pragma unroll
    for (int i = 0; i < 16; ++i) a += ((allow >> i) & 1u) ? ex2(s[i] - mn) : 0.f;
    l = l * ex2(m - mn) + a; m = mn;
}
__device__ __forceinline__ bf16x8 pack8(float a0, float a1, float a2, float a3, float a4, float a5, float a6, float a7) {
    v4u w; w.x = cvtpk(a0, a1); w.y = cvtpk(a2, a3); w.z = cvtpk(a4, a5); w.w = cvtpk(a6, a7); return __builtin_bit_cast(bf16x8, w); }
__device__ __forceinline__ void pv_tile(f32x16 (&o)[4], const bf16* vp, int dtstride, const bf16x8 pf0, const bf16x8 pf1) {
#pragma unroll
    for (int dt = 0; dt < 4; ++dt) { o[dt] = MFMA32(ldg8(vp + (size_t)dt * dtstride), pf0, o[dt]); o[dt] = MFMA32(ldg8(vp + (size_t)dt * dtstride + 512), pf1, o[dt]); }
}
__device__ __forceinline__ void imp_accum(const float (&pn)[16], int T, int j, int h, LAS float* row) {
    float ps[16];
#pragma unroll
    for (int i = 0; i < 16; ++i) { float v = pn[i]; v += shx<1>(v); v += shx<2>(v); ps[i] = v; }
    const float eA0 = ps[0] + ps[1] + ps[2] + 0.5f * ps[3], eA1 = 0.5f * ps[3] + ps[4] + ps[5] + ps[6] + 0.5f * ps[7], eA2 = 0.5f * ps[7];
    const float eB0 = ps[8] + ps[9] + ps[10] + 0.5f * ps[11], eB1 = 0.5f * ps[11] + ps[12] + ps[13] + ps[14] + 0.5f * ps[15], eB2 = 0.5f * ps[15];
    const int bA = 8 * T + 2 * h, bB = bA + 4;
    if (j == 0 && h == 0) { row[bA] += eA0; row[bA + 1] += eA1; row[bA + 2] += eA2; row[bB] += eB0; row[bB + 1] += eB1; row[bB + 2] += eB2; }
    LDS_WAIT(); asm volatile("" ::: "memory");
    if (j == 0 && h == 1) { row[bA] += eA0; row[bA + 1] += eA1; row[bA + 2] += eA2; row[bB] += eB0; row[bB + 1] += eB1; row[bB + 2] += eB2; }
    LDS_WAIT(); asm volatile("" ::: "memory");
}
template <bool IMP, class MaskF>
__device__ __forceinline__ void nsa_branch(const bf16* kt, const bf16* vt, int dtstride, int T0, int T1, const bf16x8 (&qf)[8], const MaskF& mf, float gate, f32x16 (&o)[4], LAS float* improw, int j, int h) {
    float m = -1e30f, l = 0.f;
    for (int T = T0; T <= T1; ++T) { const unsigned allow = mf(T); if (!__any(allow != 0u)) continue;
        const f32x16 s = qk_tile<8>(kt + (size_t)T * 4096, qf); stat_update(m, l, s, allow); }
    l += shx<32>(l);
    const float inv = l > 0.f ? 1.0f / l : 0.f;
    for (int T = T0; T <= T1; ++T) { const unsigned allow = mf(T); if (!__any(allow != 0u)) continue;
        const f32x16 s = qk_tile<8>(kt + (size_t)T * 4096, qf);
        float pn[16];
#pragma unroll
        for (int i = 0; i < 16; ++i) pn[i] = ((allow >> i) & 1u) ? ex2(s[i] - m) * inv : 0.f;
        if (IMP) imp_accum(pn, T, j, h, improw);
        const bf16x8 pf0 = pack8(pn[0] * gate, pn[1] * gate, pn[2] * gate, pn[3] * gate, pn[4] * gate, pn[5] * gate, pn[6] * gate, pn[7] * gate);
        const bf16x8 pf1 = pack8(pn[8] * gate, pn[9] * gate, pn[10] * gate, pn[11] * gate, pn[12] * gate, pn[13] * gate, pn[14] * gate, pn[15] * gate);
        pv_tile(o, vt + (size_t)T * 1024, dtstride, pf0, pf1); }
}
__device__ __forceinline__ void nsa_unit(const Params& p, int u, LAS unsigned char* lds, int wave, int lane) {
    unsigned char* ws = p.ws;
    const int bg = u & 3, b = bg >> 1, g = bg & 1, pi = u >> 2;
    const int tb = (wave >> 2) ? 127 - pi : pi, t0w = 32 * tb + 8 * (wave & 3);
    const int c = lane & 31, h = lane >> 5, ti = c >> 2, j = c & 3, t = t0w + ti, head = 4 * g + j;
    const float* gt = (const float*)(ws + WS_GATES) + (size_t)(b * 4096 + t) * 24 + head * 3;
    const float g_c = gt[0], g_s = gt[1], g_w = gt[2];
    const bf16* nat = (const bf16*)(ws + WS_NAT);
    const bf16* qb = nat + (size_t)((16 + head) * 2 + b) * (4096 * 128);
    bf16x8 qf[8];
#pragma unroll
    for (int st = 0; st < 8; ++st) qf[st] = ldg8(qb + ((size_t)(((t >> 5) * 8 + st) * 64 + h * 32 + (t & 31))) * 8);
    f32x16 o[4];
#pragma unroll
    for (int dt = 0; dt < 4; ++dt)
#pragma unroll
        for (int i = 0; i < 16; ++i) o[dt][i] = 0.f;
    LAS float* imp = (LAS float*)(lds + wave * 2304);
    LAS unsigned* selm = (LAS unsigned*)(lds + 8 * 2304 + wave * 64);
    for (int i = lane; i < 8 * 68; i += 64) imp[i] = 0.f;
    LDS_WAIT(); asm volatile("" ::: "memory");
    {
        const int nv = t >= 31 ? ((t - 31) >> 4) + 1 : 0;
        const int nvmax = (t0w + 7) >= 31 ? ((t0w + 7 - 31) >> 4) + 1 : 0;
        const int NT = (nvmax + 31) >> 5;
        const bf16* kt = (const bf16*)(ws + WS_KC) + (size_t)(b * 2 + g) * (256 * 128) + lane * 8;
        const bf16* vt = (const bf16*)(ws + WS_VCT) + (size_t)(b * 2 + g) * (256 * 128) + lane * 8;
        auto mf = [=](int T) -> unsigned { return mask_le(32 * T + 8 * h, nv - 1); };
        nsa_branch<true>(kt, vt, 8 * 1024, 0, NT - 1, qf, mf, g_c, o, imp + ti * 68, j, h);
    }
    {
        const int tk = lane >> 3, sub = lane & 7, cur = t0w >> 6;
        const LAS float* row = imp + tk * 68;
        float sc[8]; int rank[8];
#pragma unroll
        for (int e = 0; e < 8; ++e) { const int mm = sub * 8 + e; const bool valid = mm <= cur, forced = (mm == 0) || (mm == cur) || (mm == cur - 1);
            sc[e] = valid ? (forced ? 3.0e38f : row[mm]) : -1.0f; rank[e] = 0; }
#pragma unroll 4
        for (int mp = 0; mp < 64; ++mp) { const bool validp = mp <= cur, forcedp = (mp == 0) || (mp == cur) || (mp == cur - 1);
            const float sp = validp ? (forcedp ? 3.0e38f : row[mp]) : -1.0f;
#pragma unroll
            for (int e = 0; e < 8; ++e) { const int mm = sub * 8 + e; rank[e] += ((sp > sc[e]) || (sp == sc[e] && mp < mm)) ? 1 : 0; } }
        unsigned byte = 0;
#pragma unroll
        for (int e = 0; e < 8; ++e) byte |= (unsigned)((sc[e] >= 0.f) && (rank[e] < 16)) << e;
        unsigned lo = sub < 4 ? byte << (8 * sub) : 0u, hi = sub >= 4 ? byte << (8 * (sub - 4)) : 0u;
        lo |= shxu<1>(lo); lo |= shxu<2>(lo); lo |= shxu<4>(lo);
        hi |= shxu<1>(hi); hi |= shxu<2>(hi); hi |= shxu<4>(hi);
        if (sub == 0) { selm[tk * 2] = lo; selm[tk * 2 + 1] = hi; }
        LDS_WAIT(); asm volatile("" ::: "memory");
    }
    const unsigned slo = selm[ti * 2], shi = selm[ti * 2 + 1];
    {
        const int cur = t0w >> 6;
        const bf16* kt = nat + (size_t)((28 + g) * 2 + b) * (4096 * 128) + lane * 8;
        const bf16* vt = (const bf16*)(ws + WS_VTT) + ((size_t)((8 + g) * 4) * 256 + b * 128) * 1024 + lane * 8;
        auto mf = [=](int T) -> unsigned { const int blk = T >> 1; const unsigned bit = blk < 32 ? (slo >> blk) & 1u : (shi >> (blk - 32)) & 1u;
            if (!bit) return 0u; return blk == cur ? mask_le(32 * T + 8 * h, t) : 0xFFFFu; };
        nsa_branch<false>(kt, vt, 256 * 1024, 0, 2 * cur + 1, qf, mf, g_s, o, imp, j, h);
    }
    {
        const int T0 = (t0w - 511 > 0 ? t0w - 511 : 0) >> 5, T1 = (t0w + 7) >> 5;
        const bf16* kt = nat + (size_t)((30 + g) * 2 + b) * (4096 * 128) + lane * 8;
        const bf16* vt = (const bf16*)(ws + WS_VTT) + ((size_t)((10 + g) * 4) * 256 + b * 128) * 1024 + lane * 8;
        auto mf = [=](int T) -> unsigned { const int kb = 32 * T + 8 * h; return mask_le(kb, t) & mask_ge(kb, t - 511); };
        nsa_branch<false>(kt, vt, 256 * 1024, T0, T1, qf, mf, g_w, o, imp, j, h);
    }
    bf16* op = (bf16*)(ws + WS_OATT) + (size_t)(b * 4096 + t) * DM + 1024 + head * 128 + 4 * h;
#pragma unroll
    for (int dt = 0; dt < 4; ++dt)
#pragma unroll
        for (int ig = 0; ig < 4; ++ig) { v2u w; w.x = cvtpk(o[dt][4 * ig], o[dt][4 * ig + 1]); w.y = cvtpk(o[dt][4 * ig + 2], o[dt][4 * ig + 3]); *(v2u*)(op + 32 * dt + 8 * ig) = w; }
}
__device__ __forceinline__ void diff_unit(const Params& p, int layer, int u, int wave, int lane) {
    unsigned char* ws = p.ws;
    const int bh = u & 15, b = bh >> 3, head = bh & 7, qi = u >> 4;
    const int qb128 = (wave >> 2) ? 31 - qi : qi, q0 = 128 * qb128 + 32 * (wave & 3);
    const int c = lane & 31, h = lane >> 5, t = q0 + c, Td = q0 >> 5;
    const bf16* nat = (const bf16*)(ws + WS_NAT);
    const bf16* qb = nat + (size_t)(head * 2 + b) * (4096 * 128);
    bf16x8 qf0[4], qf1[4];
#pragma unroll
    for (int st = 0; st < 4; ++st) { qf0[st] = ldg8(qb + ((size_t)(((t >> 5) * 8 + st) * 64 + h * 32 + (t & 31))) * 8); qf1[st] = ldg8(qb + ((size_t)(((t >> 5) * 8 + 4 + st) * 64 + h * 32 + (t & 31))) * 8); }
    const bf16* kt = nat + (size_t)((8 + head) * 2 + b) * (4096 * 128) + lane * 8;
    const bf16* vt = (const bf16*)(ws + WS_VTT) + ((size_t)(head * 4) * 256 + b * 128) * 1024 + lane * 8;
    float m0 = -1e30f, l0 = 0.f, m1 = -1e30f, l1 = 0.f;
    for (int T = 0; T <= Td; ++T) { const unsigned allow = T == Td ? mask_le(32 * T + 8 * h, t) : 0xFFFFu;
        const f32x16 s0 = qk_tile<4>(kt + (size_t)T * 4096, qf0); stat_update(m0, l0, s0, allow);
        const f32x16 s1 = qk_tile<4>(kt + (size_t)T * 4096 + 2048, qf1); stat_update(m1, l1, s1, allow); }
    l0 += shx<32>(l0); l1 += shx<32>(l1);
    const float* lm = (const float*)(ws + WS_LAM) + layer * 2;
    const float il0 = 1.0f / l0, il1 = lm[0] / l1;
    f32x16 o[4];
#pragma unroll
    for (int dt = 0; dt < 4; ++dt)
#pragma unroll
        for (int i = 0; i < 16; ++i) o[dt][i] = 0.f;
    for (int T = 0; T <= Td; ++T) { const unsigned allow = T == Td ? mask_le(32 * T + 8 * h, t) : 0xFFFFu;
        const f32x16 s0 = qk_tile<4>(kt + (size_t)T * 4096, qf0); const f32x16 s1 = qk_tile<4>(kt + (size_t)T * 4096 + 2048, qf1);
        float a[16];
#pragma unroll
        for (int i = 0; i < 16; ++i) a[i] = ((allow >> i) & 1u) ? ex2(s0[i] - m0) * il0 - ex2(s1[i] - m1) * il1 : 0.f;
        pv_tile(o, vt + (size_t)T * 1024, 256 * 1024, pack8(a[0], a[1], a[2], a[3], a[4], a[5], a[6], a[7]), pack8(a[8], a[9], a[10], a[11], a[12], a[13], a[14], a[15])); }
    float ss = 0.f;
#pragma unroll
    for (int dt = 0; dt < 4; ++dt)
#pragma unroll
        for (int i = 0; i < 16; ++i) ss += o[dt][i] * o[dt][i];
    ss += shx<32>(ss);
    const float r = rsqrtf(ss * (1.0f / 128.0f) + RMS_EPS) * lm[1];
    const float* sg = p.diff_subln + layer * 128 + 4 * h;
    bf16* op = (bf16*)(ws + WS_OATT) + (size_t)(b * 4096 + t) * DM + head * 128 + 4 * h;
#pragma unroll
    for (int dt = 0; dt < 4; ++dt)
#pragma unroll
        for (int ig = 0; ig < 4; ++ig) { const f32x4 gv = *(const f32x4*)(sg + 32 * dt + 8 * ig);
            v2u w; w.x = cvtpk(o[dt][4 * ig] * r * gv[0], o[dt][4 * ig + 1] * r * gv[1]); w.y = cvtpk(o[dt][4 * ig + 2] * r * gv[2], o[dt][4 * ig + 3] * r * gv[3]); *(v2u*)(op + 32 * dt + 8 * ig) = w; }
}
constexpr int ATT_STAGE = 32768, ATT_VOFF = 16384;
constexpr int ATT_EXTRA = 131072 + 1024;
__device__ __forceinline__ void att_wait_bar() { asm volatile("s_waitcnt vmcnt(0) lgkmcnt(0)\n\ts_barrier" ::: "memory"); }
__device__ __forceinline__ void dma_frag(const bf16* gsrc_uniform, unsigned lane8, LAS unsigned char* dst) {
    __builtin_amdgcn_global_load_lds((const unsigned*)(gsrc_uniform + lane8), (LAS unsigned*)dst, 16, 0, 0);
}
__device__ __forceinline__ unsigned m32_le(int kb, int lim) { unsigned r = 0;
#pragma unroll
    for (int q = 0; q < 32; ++q) r |= (unsigned)((kb + 32 * (q >> 4) + (q & 7) + 16 * ((q >> 3) & 1)) <= lim) << q;
    return r; }
__device__ __forceinline__ unsigned m32_ge(int kb, int lim) { unsigned r = 0;
#pragma unroll
    for (int q = 0; q < 32; ++q) r |= (unsigned)((kb + 32 * (q >> 4) + (q & 7) + 16 * ((q >> 3) & 1)) >= lim) << q;
    return r; }
template <int NQK>
__device__ __forceinline__ f32x16 qk32(const LAS unsigned char* stg, int sub, const bf16x8 (&qf)[NQK], int lane) {
    const LAS unsigned char* kp = stg + sub * (NQK * 1024) + lane * 16;
    f32x16 s;
#pragma unroll
    for (int i = 0; i < 16; ++i) s[i] = 0.f;
#pragma unroll
    for (int st = 0; st < NQK; ++st) s = MFMA32(*(const LAS bf16x8*)(kp + st * 1024), qf[st], s);
    return s;
}
__device__ __forceinline__ void pv32(f32x16 (&o)[4], const LAS unsigned char* stg, int sub, const bf16x8 pf0, const bf16x8 pf1, int lane) {
    const LAS unsigned char* vp = stg + ATT_VOFF + sub * 2048 + lane * 16;
#pragma unroll
    for (int dt = 0; dt < 4; ++dt) { o[dt] = MFMA32(*(const LAS bf16x8*)(vp + dt * 4096), pf0, o[dt]); o[dt] = MFMA32(*(const LAS bf16x8*)(vp + dt * 4096 + 1024), pf1, o[dt]); }
}
__device__ __forceinline__ void online32(float& m, float& l, f32x16 (&o)[4], f32x16& s, unsigned allow, bf16x8& pf0, bf16x8& pf1) {
    float tm = -1e30f;
#pragma unroll
    for (int i = 0; i < 16; ++i) tm = fmaxf(tm, ((allow >> i) & 1u) ? s[i] : -1e30f);
    tm = fmaxf(tm, shx<32>(tm));
    const float mn = fmaxf(m, tm);
    if (!__all(mn == m)) { const float alpha = ex2(m - mn); l *= alpha; m = mn;
#pragma unroll
        for (int dt = 0; dt < 4; ++dt)
#pragma unroll
            for (int i = 0; i < 16; ++i) o[dt][i] *= alpha; }
    float a = 0.f;
#pragma unroll
    for (int i = 0; i < 16; ++i) { s[i] = ((allow >> i) & 1u) ? ex2(s[i] - m) : 0.f; a += s[i]; }
    l += a;
    pf0 = pack8(s[0], s[1], s[2], s[3], s[4], s[5], s[6], s[7]); pf1 = pack8(s[8], s[9], s[10], s[11], s[12], s[13], s[14], s[15]);
}
__device__ __forceinline__ void stash_store(float* scr, const f32x16 (&o)[4], float scale, int lane) {
    float* sp = scr + lane;
#pragma unroll
    for (int dt = 0; dt < 4; ++dt)
#pragma unroll
        for (int i = 0; i < 16; ++i) sp[(dt * 16 + i) * 64] = o[dt][i] * scale;
}
__device__ __forceinline__ void diff_engine(const Params& p, int layer, int u, LAS unsigned char* lds, int bid, int wave, int lane) {
    unsigned char* ws = p.ws;
    const int bh = u & 15, b = bh >> 3, head = bh & 7, qi = u >> 4;
    const int qb128 = (wave >> 2) ? 31 - qi : qi, qw = 128 * qb128 + 32 * (wave & 3);
    const int c = lane & 31, h = lane >> 5, t = qw + c;
    const bf16* nat = (const bf16*)(ws + WS_NAT);
    const bf16* qb = nat + (size_t)(head * 2 + b) * (4096 * 128);
    const bf16* kbase = nat + (size_t)((8 + head) * 2 + b) * (4096 * 128);
    const bf16* vbase = (const bf16*)(ws + WS_VTT) + ((size_t)(head * 4) * 256 + b * 128) * 1024;
    const unsigned lane8 = (unsigned)lane * 8u;
    float* scr = (float*)(ws + WS_SCR) + (size_t)(bid * NWAVES + wave) * 4096;
    const int NT = 2 * (32 - qi), NS = 2 * NT;
    auto issue = [&](int step) {
        const int cc = step >= NT ? 1 : 0, T = step - cc * NT;
        LAS unsigned char* stg = lds + (step & 1) * ATT_STAGE;
        if (wave < 4) {
#pragma unroll
            for (int i = 0; i < 2; ++i) { const int jf = 2 * wave + i, sub = jf >> 2, st = jf & 3;
                dma_frag(kbase + (size_t)(((2 * T + sub) * 8 + 4 * cc + st)) * 512, lane8, stg + jf * 1024); }
        } else { const int dt = wave - 4;
#pragma unroll
            for (int i = 0; i < 4; ++i) dma_frag(vbase + (size_t)dt * (256 * 1024) + (size_t)T * 2048 + i * 512, lane8, stg + ATT_VOFF + (dt * 4 + i) * 1024); }
    };
    bf16x8 qf[4]; f32x16 o[4]; float m = -1e30f, l = 0.f;
    issue(0);
    for (int step = 0; step < NS; ++step) {
        att_wait_bar();
        if (step + 1 < NS) issue(step + 1);
        const int cc = step >= NT ? 1 : 0, T = step - cc * NT;
        if (T == 0) {
#pragma unroll
            for (int st = 0; st < 4; ++st) qf[st] = ldg8(qb + ((size_t)(((t >> 5) * 8 + 4 * cc + st) * 64 + h * 32 + (t & 31))) * 8);
            m = -1e30f; l = 0.f;
#pragma unroll
            for (int dt = 0; dt < 4; ++dt)
#pragma unroll
                for (int i = 0; i < 16; ++i) o[dt][i] = 0.f;
        }
        if (64 * T <= qw + 31) {
            const LAS unsigned char* stg = lds + (step & 1) * ATT_STAGE;
            const unsigned allow = (64 * T + 63 > qw) ? m32_le(64 * T + 8 * h, t) : 0xFFFFFFFFu;
#pragma unroll 1
            for (int sub = 0; sub < 2; ++sub) {
                f32x16 s = qk32<4>(stg, sub, qf, lane);
                bf16x8 pf0, pf1; online32(m, l, o, s, (allow >> (16 * sub)) & 0xFFFFu, pf0, pf1);
                pv32(o, stg, sub, pf0, pf1, lane);
                __builtin_amdgcn_sched_barrier(0);
            }
        }
        if (T == NT - 1) {
            int ll = lane, tt = t; asm volatile("" : "+v"(ll), "+v"(tt));
            l += shx<32>(l);
            const float* lm = (const float*)(ws + WS_LAM) + layer * 2;
            if (cc == 0) stash_store(scr, o, 1.0f / l, ll);
            else {
                const float il1 = lm[0] / l;
                float ss = 0.f;
#pragma unroll
                for (int dt = 0; dt < 4; ++dt)
#pragma unroll
                    for (int i = 0; i < 16; ++i) { const float v = (scr + ll)[(dt * 16 + i) * 64] - o[dt][i] * il1; o[dt][i] = v; ss += v * v; }
                ss += shx<32>(ss);
                const float r = rsqrtf(ss * (1.0f / 128.0f) + RMS_EPS) * lm[1];
                const int hh2 = ll >> 5;
                const float* sg = p.diff_subln + layer * 128 + 4 * hh2;
                bf16* op = (bf16*)(ws + WS_OATT) + (size_t)(b * 4096 + tt) * DM + head * 128 + 4 * hh2;
#pragma unroll
                for (int dt = 0; dt < 4; ++dt)
#pragma unroll
                    for (int ig = 0; ig < 4; ++ig) { const f32x4 gv = *(const f32x4*)(sg + 32 * dt + 8 * ig);
                        v2u w; w.x = cvtpk(o[dt][4 * ig] * r * gv[0], o[dt][4 * ig + 1] * r * gv[1]); w.y = cvtpk(o[dt][4 * ig + 2] * r * gv[2], o[dt][4 * ig + 3] * r * gv[3]); *(v2u*)(op + 32 * dt + 8 * ig) = w; }
            }
        }
    }
    att_wait_bar();
}
__device__ __forceinline__ void nsa_engine(const Params& p, int u, LAS unsigned char* lds, int bid, int wave, int lane) {
    unsigned char* ws = p.ws;
    const int bg = u & 3, b = bg >> 1, g = bg & 1, pi = u >> 2;
    const int tb = (wave >> 2) ? 127 - pi : pi, t0w = 32 * tb + 8 * (wave & 3);
    const int c = lane & 31, h = lane >> 5, ti = c >> 2, j = c & 3, t = t0w + ti, head = 4 * g + j;
    const float* gt = (const float*)(ws + WS_GATES) + (size_t)(b * 4096 + t) * 24 + head * 3;
    const float g_c = gt[0], g_s = gt[1], g_w = gt[2];
    const bf16* nat = (const bf16*)(ws + WS_NAT);
    const bf16* qb = nat + (size_t)((16 + head) * 2 + b) * (4096 * 128);
    bf16x8 qf[8];
#pragma unroll
    for (int st = 0; st < 8; ++st) qf[st] = ldg8(qb + ((size_t)(((t >> 5) * 8 + st) * 64 + h * 32 + (t & 31))) * 8);
    float* scr = (float*)(ws + WS_SCR) + (size_t)(bid * NWAVES + wave) * 4096;
    LAS float* imp = (LAS float*)(lds + ATT_EXTRA + wave * 2176);
    LAS unsigned* selm = (LAS unsigned*)(lds + ATT_EXTRA + 8 * 2176 + wave * 64);
    for (int i = lane; i < 8 * 68; i += 64) imp[i] = 0.f;
    const int tA = 32 * pi, tB = 32 * (127 - pi);
    const int nvB = ((tB + 31 - 31) >> 4) + 1;
    const int NTc = (nvB + 63) >> 6;
    const int curB = tB >> 6, NSel = curB + 1;
    const int wA0 = (tA - 511 > 0 ? tA - 511 : 0) >> 6, wA1 = (tA + 31) >> 6, wB0 = (tB - 511) >> 6, wB1 = (tB + 31) >> 6;
    const int gap = wB0 > wA1 + 1 ? wB0 - (wA1 + 1) : 0;
    const int NWin = (wB1 - wA0 + 1) - gap;
    const unsigned lane8 = (unsigned)lane * 8u;
    const bf16* kc = (const bf16*)(ws + WS_KC) + (size_t)(b * 2 + g) * (256 * 128);
    const bf16* vc = (const bf16*)(ws + WS_VCT) + (size_t)(b * 2 + g) * (256 * 128);
    const bf16* ksel = nat + (size_t)((28 + g) * 2 + b) * (4096 * 128);
    const bf16* kwin = nat + (size_t)((30 + g) * 2 + b) * (4096 * 128);
    const bf16* vsel = (const bf16*)(ws + WS_VTT) + ((size_t)((8 + g) * 4) * 256 + b * 128) * 1024;
    const bf16* vwin = (const bf16*)(ws + WS_VTT) + ((size_t)((10 + g) * 4) * 256 + b * 128) * 1024;
    auto issue = [&](const bf16* kb, const bf16* vb, size_t dtstride, int T, int step) {
        LAS unsigned char* stg = lds + (step & 1) * ATT_STAGE;
        if (wave < 4) {
#pragma unroll
            for (int i = 0; i < 4; ++i) dma_frag(kb + (size_t)T * 8192 + (4 * wave + i) * 512, lane8, stg + (4 * wave + i) * 1024);
        } else if (vb != nullptr) { const int dt = wave - 4;
#pragma unroll
            for (int i = 0; i < 4; ++i) dma_frag(vb + (size_t)dt * dtstride + (size_t)T * 2048 + i * 512, lane8, stg + ATT_VOFF + (dt * 4 + i) * 1024); }
    };
    auto win_tile = [&](int k) -> int { int w = wA0 + k; if (w > wA1) w += gap; return w; };
    const int nv = t >= 31 ? ((t - 31) >> 4) + 1 : 0, cur = t0w >> 6;
    f32x16 o[4]; float m = -1e30f, l = 0.f, inv_c = 0.f; unsigned slo = 0u, shi = 0u;
    int step = 0;
    issue(kc, nullptr, 0, 0, 0);
    for (int T = 0; T < NTc; ++T, ++step) {
        att_wait_bar();
        if (T + 1 < NTc) issue(kc, nullptr, 0, T + 1, step + 1); else issue(kc, vc, 8192, 0, step + 1);
        const LAS unsigned char* stg = lds + (step & 1) * ATT_STAGE;
        const unsigned allow = m32_le(64 * T + 8 * h, nv - 1);
        if (__any(allow != 0u)) {
#pragma unroll 1
            for (int sub = 0; sub < 2; ++sub) { const unsigned al = (allow >> (16 * sub)) & 0xFFFFu;
                const f32x16 s = qk32<8>(stg, sub, qf, lane);
                float tm = -1e30f;
#pragma unroll
                for (int i = 0; i < 16; ++i) tm = fmaxf(tm, ((al >> i) & 1u) ? s[i] : -1e30f);
                tm = fmaxf(tm, shx<32>(tm));
                const float mn = fmaxf(m, tm); float a = 0.f;
#pragma unroll
                for (int i = 0; i < 16; ++i) a += ((al >> i) & 1u) ? ex2(s[i] - mn) : 0.f;
                l = l * ex2(m - mn) + a; m = mn;
                __builtin_amdgcn_sched_barrier(0); } }
    }
    l += shx<32>(l); inv_c = l > 0.f ? 1.0f / l : 0.f;
#pragma unroll
    for (int dt = 0; dt < 4; ++dt)
#pragma unroll
        for (int i = 0; i < 16; ++i) o[dt][i] = 0.f;
    for (int T = 0; T < NTc; ++T, ++step) {
        att_wait_bar();
        if (T + 1 < NTc) issue(kc, vc, 8192, T + 1, step + 1); else issue(ksel, vsel, 256 * 1024, 0, step + 1);
        const LAS unsigned char* stg = lds + (step & 1) * ATT_STAGE;
        const unsigned allow = m32_le(64 * T + 8 * h, nv - 1);
        if (__any(allow != 0u)) {
#pragma unroll 1
            for (int sub = 0; sub < 2; ++sub) { const unsigned al = (allow >> (16 * sub)) & 0xFFFFu;
                const f32x16 s = qk32<8>(stg, sub, qf, lane);
                float pn[16];
#pragma unroll
                for (int i = 0; i < 16; ++i) pn[i] = ((al >> i) & 1u) ? ex2(s[i] - m) * inv_c : 0.f;
                imp_accum(pn, 2 * T + sub, j, h, imp + ti * 68);
                const bf16x8 pf0 = pack8(pn[0] * g_c, pn[1] * g_c, pn[2] * g_c, pn[3] * g_c, pn[4] * g_c, pn[5] * g_c, pn[6] * g_c, pn[7] * g_c);
                const bf16x8 pf1 = pack8(pn[8] * g_c, pn[9] * g_c, pn[10] * g_c, pn[11] * g_c, pn[12] * g_c, pn[13] * g_c, pn[14] * g_c, pn[15] * g_c);
                pv32(o, stg, sub, pf0, pf1, lane);
                __builtin_amdgcn_sched_barrier(0); } }
    }
    {
        int ll = lane; asm volatile("" : "+v"(ll));
        stash_store(scr, o, 1.0f, ll);
        const int tk = ll >> 3, sub = ll & 7;
        const LAS float* row = imp + tk * 68;
        float sc[8]; int rank[8];
#pragma unroll
        for (int e = 0; e < 8; ++e) { const int mm = sub * 8 + e; const bool valid = mm <= cur, forced = (mm == 0) || (mm == cur) || (mm == cur - 1);
            sc[e] = valid ? (forced ? 3.0e38f : row[mm]) : -1.0f; rank[e] = 0; }
#pragma unroll 4
        for (int mp = 0; mp < 64; ++mp) { const bool validp = mp <= cur, forcedp = (mp == 0) || (mp == cur) || (mp == cur - 1);
            const float sp = validp ? (forcedp ? 3.0e38f : row[mp]) : -1.0f;
#pragma unroll
            for (int e = 0; e < 8; ++e) { const int mm = sub * 8 + e; rank[e] += ((sp > sc[e]) || (sp == sc[e] && mp < mm)) ? 1 : 0; } }
        unsigned byte = 0;
#pragma unroll
        for (int e = 0; e < 8; ++e) byte |= (unsigned)((sc[e] >= 0.f) && (rank[e] < 16)) << e;
        unsigned lo = sub < 4 ? byte << (8 * sub) : 0u, hi = sub >= 4 ? byte << (8 * (sub - 4)) : 0u;
        lo |= shxu<1>(lo); lo |= shxu<2>(lo); lo |= shxu<4>(lo);
        hi |= shxu<1>(hi); hi |= shxu<2>(hi); hi |= shxu<4>(hi);
        if (sub == 0) { selm[tk * 2] = lo; selm[tk * 2 + 1] = hi; }
        LDS_WAIT(); asm volatile("" ::: "memory");
        { const int ti2 = (ll & 31) >> 2; slo = selm[ti2 * 2]; shi = selm[ti2 * 2 + 1]; }
    }
    auto reset = [&]() { m = -1e30f; l = 0.f;
#pragma unroll
        for (int dt = 0; dt < 4; ++dt)
#pragma unroll
            for (int i = 0; i < 16; ++i) o[dt][i] = 0.f; };
    auto tile = [&](const LAS unsigned char* stg, unsigned allow) {
        if (__any(allow != 0u)) {
#pragma unroll 1
            for (int sub = 0; sub < 2; ++sub) {
                f32x16 s = qk32<8>(stg, sub, qf, lane);
                bf16x8 pf0, pf1; online32(m, l, o, s, (allow >> (16 * sub)) & 0xFFFFu, pf0, pf1);
                pv32(o, stg, sub, pf0, pf1, lane);
                __builtin_amdgcn_sched_barrier(0); } } };
    reset();
    for (int T = 0; T < NSel; ++T, ++step) {
        att_wait_bar();
        if (T + 1 < NSel) issue(ksel, vsel, 256 * 1024, T + 1, step + 1); else issue(kwin, vwin, 256 * 1024, win_tile(0), step + 1);
        const unsigned bit = T < 32 ? (slo >> T) & 1u : (shi >> (T - 32)) & 1u;
        const unsigned allow = bit ? (T == cur ? m32_le(64 * T + 8 * h, t) : 0xFFFFFFFFu) : 0u;
        tile(lds + (step & 1) * ATT_STAGE, allow);
    }
    {
        int ll = lane; asm volatile("" : "+v"(ll));
        l += shx<32>(l);
        const float sc = g_s / l;
        float* sp = scr + ll;
#pragma unroll
        for (int dt = 0; dt < 4; ++dt)
#pragma unroll
            for (int i = 0; i < 16; ++i) sp[(dt * 16 + i) * 64] += o[dt][i] * sc;
    }
    reset();
    for (int k = 0; k < NWin; ++k, ++step) {
        att_wait_bar();
        if (k + 1 < NWin) issue(kwin, vwin, 256 * 1024, win_tile(k + 1), step + 1);
        const int T = win_tile(k);
        const unsigned allow = (64 * T + 63 >= t0w - 511 && 64 * T <= t0w + 7) ? (m32_le(64 * T + 8 * h, t) & m32_ge(64 * T + 8 * h, t - 511)) : 0u;
        tile(lds + (step & 1) * ATT_STAGE, allow);
    }
    {
        int ll = lane, tt = t; asm volatile("" : "+v"(ll), "+v"(tt));
        l += shx<32>(l);
        const float sc = g_w / l;
        const float* sp = scr + ll;
        bf16* op = (bf16*)(ws + WS_OATT) + (size_t)(b * 4096 + tt) * DM + 1024 + (4 * g + (ll & 3)) * 128 + 4 * (ll >> 5);
#pragma unroll
        for (int dt = 0; dt < 4; ++dt)
#pragma unroll
            for (int ig = 0; ig < 4; ++ig) { float v[4];
#pragma unroll
                for (int e = 0; e < 4; ++e) v[e] = sp[(dt * 16 + 4 * ig + e) * 64] + o[dt][4 * ig + e] * sc;
                v2u w; w.x = cvtpk(v[0], v[1]); w.y = cvtpk(v[2], v[3]); *(v2u*)(op + 32 * dt + 8 * ig) = w; }
    }
    att_wait_bar();
}
#define LAUNDER_V(x) asm volatile("" : "+v"(x))
#define LAUNDER_S(x) asm volatile("" : "+s"(x))
template <int PH>
__device__ __forceinline__ void run_phase(int it, LAS unsigned char* lds, int wave_s) {
    const __attribute__((address_space(4))) Params* pp_ = (const __attribute__((address_space(4))) Params*)__builtin_amdgcn_kernarg_segment_ptr(); LAUNDER_S(pp_);
#if defined(__HIP_DEVICE_COMPILE__)
    const Params p = *pp_;
#else
    const Params p{};
#endif
    int wv_ = wave_s; LAUNDER_S(wv_);
    int ln_; asm volatile("v_mbcnt_lo_u32_b32 %0, -1, 0\n\tv_mbcnt_hi_u32_b32 %0, -1, %0" : "=v"(ln_));
    int tid = wv_ * 64 + ln_;
    int bid = blockIdx.x, G = gridDim.x; LAUNDER_S(bid); LAUNDER_S(G);
    unsigned char* ws = p.ws; LAUNDER_S(ws);
    const int lane = tid & 63, wave = __builtin_amdgcn_readfirstlane(tid >> 6), gw = bid * NWAVES + wave, NGW = G * NWAVES;
    const int l = it >> 1, f = it & 1, sub = f ? 2 : 0;
    const float* modl = (const float*)(ws + WS_MOD) + (size_t)l * 2 * NMOD * DM;
    bf16* const H = (bf16*)(ws + WS_H); bf16* const ACT = (bf16*)(ws + WS_ACT); bf16* const OATT = (bf16*)(ws + WS_OATT);
    float* const X = p.out;
    if constexpr (PH == 8) prologue(p, lds, bid, G, tid, wave, lane);
    if constexpr (PH == 9) final_norm_phase(X, p.final_g, gw, NGW, lane);
    if constexpr (PH == 0) norm_phase(X, p.norm_g + (size_t)(l * 3 + sub) * DM, modl + (3 * sub) * DM, modl + (3 * sub + 1) * DM, (size_t)NMOD * DM, H, gw, NGW, lane);
    if constexpr (PH == 3) norm_phase(X, p.norm_g + (size_t)(l * 3 + 1) * DM, modl + 3 * DM, modl + 4 * DM, (size_t)NMOD * DM, H, gw, NGW, lane);
    if constexpr (PH == 1) {
        pg8::Gemm g{H, (const bf16*)(ws + WS_WGU) + (size_t)(l * 2 + f) * NGU * DM, MTOK, NGU, DM}; pg8::StaticOrder S; S.init(MTOK, NGU, G, bid);
        pg8::EpiSwiglu E{ACT, DFF};
        pg8::gemm_phase<pg8::EpiSwiglu, pg8::StaticOrder, PG8_ALIGN, PG8_SP2>(lds + RING_OFF, g, S, E, tid);
    }
    if constexpr (PH == 2) {
        pg8::Gemm g{ACT, (const bf16*)(ws + WS_WD) + (size_t)(l * 2 + f) * DM * DFF, MTOK, DM, DFF}; pg8::StaticOrder S; S.init(MTOK, DM, G, bid);
        pg8::EpiResid E{X, modl + (3 * sub + 2) * DM, NMOD * DM, 0.5f};
        pg8::gemm_phase<pg8::EpiResid, pg8::StaticOrder, PG8_ALIGN, PG8_SP2>(lds + RING_OFF, g, S, E, tid);
    }
    if constexpr (PH == 4) {
        { pg8::Gemm g{H, (const bf16*)(ws + WS_WNAT) + (size_t)l * NATN * DM, MTOK, NATN, DM}; pg8::StaticOrder S; S.init(MTOK, NATN, G, bid);
          pg8::EpiNat E{(bf16*)(ws + WS_NAT), (float*)(ws + WS_GATES), (const float*)(ws + WS_ROPE), 0.125f * LOG2E, 0.08838834764831845f * LOG2E};
          pg8::gemm_phase<pg8::EpiNat, pg8::StaticOrder, PG8_ALIGN, PG8_SP2>(lds + RING_OFF, g, S, E, tid); }
        { pg8::Gemm g{(const bf16*)(ws + WS_WV) + (size_t)l * VTN * DM, H, VTN, MTOK, DM}; pg8::StaticOrder S; S.init(VTN, MTOK, G, G - 1 - bid);
          pg8::EpiVT E{(bf16*)(ws + WS_VTT)};
          pg8::gemm_phase<pg8::EpiVT, pg8::StaticOrder, PG8_ALIGN, PG8_SP2>(lds + RING_OFF, g, S, E, tid); }
    }
    if constexpr (PH == 5) {
        for (int u = bid; u < 128; u += G) compress_unit(p, l, u, lds, tid, wave, lane);
#if ATTN_V2
        for (int u = bid; u < 256; u += G) diff_engine(p, l, u, lds, bid, wave, lane);
#else
        for (int u = bid; u < 256; u += G) diff_unit(p, l, u, wave, lane);
#endif
    }
#if ATTN_V2
    if constexpr (PH == 6) { for (int u = bid; u < 256; u += G) nsa_engine(p, u, lds, bid, wave, lane); }
#else
    if constexpr (PH == 6) { for (int u = bid; u < 256; u += G) nsa_unit(p, u, lds, wave, lane); }
#endif
    if constexpr (PH == 7) {
        pg8::Gemm g{OATT, (const bf16*)(ws + WS_WO) + (size_t)l * DM * DM, MTOK, DM, DM}; pg8::StaticOrder S; S.init(MTOK, DM, G, bid);
        pg8::EpiResid E{X, modl + 5 * DM, NMOD * DM, 1.0f};
        pg8::gemm_phase<pg8::EpiResid, pg8::StaticOrder, PG8_ALIGN, PG8_SP2>(lds + RING_OFF, g, S, E, tid);
    }
}
template <int PH>
__global__ void __launch_bounds__(NWAVES * 64, 2) phase_kernel(Params p) {
    extern __shared__ __attribute__((aligned(16))) unsigned char lds_raw[];
    run_phase<PH>(p.one_it, (LAS unsigned char*)lds_raw, __builtin_amdgcn_readfirstlane(threadIdx.x >> 6));
}
__global__ void __launch_bounds__(NWAVES * 64, 2) mega_fwd(Params p) {
    extern __shared__ __attribute__((aligned(16))) unsigned char lds_raw[];
    LAS unsigned char* lds = (LAS unsigned char*)lds_raw;
    for (int u = threadIdx.x; u < (LDS_BYTES - LDSCTL_OFF) / 4; u += NWAVES * 64) ((LAS unsigned*)(lds + LDSCTL_OFF))[u] = 0u;
    __syncthreads();
    const int wave_s = __builtin_amdgcn_readfirstlane(threadIdx.x >> 6);
    const int sel_it = p.one_it, sel_ph = p.one_ph; int it_ = 0;
    if (sel_it < 0) (void)xcd_barrier_post((unsigned*)(p.ws + WS_CTL) + CW_BAR, (volatile LAS unsigned*)(lds + MISC_OFF) + 8);
#define GRID_BAR() do { const __attribute__((address_space(4))) Params* q_ = (const __attribute__((address_space(4))) Params*)__builtin_amdgcn_kernarg_segment_ptr(); LAUNDER_S(q_); \
        XcdBarrier b_; b_.bar = (unsigned*)(q_->ws + WS_CTL) + CW_BAR; b_.x = xb_xcc_id(); b_.st = (volatile LAS unsigned*)(lds + MISC_OFF) + 8; { int w0_ = wave_s; LAUNDER_S(w0_); unsigned l0_; asm volatile("v_mbcnt_lo_u32_b32 %0, -1, 0\n\tv_mbcnt_hi_u32_b32 %0, -1, %0" : "=v"(l0_)); b_.t0 = (w0_ == 0) && (l0_ == 0u); } if (sel_it < 0) { xcd_barrier(b_); if (BAR_TWICE) xcd_barrier(b_); } } while (0)
#ifndef BAR_TWICE
#define BAR_TWICE 0
#endif
#ifndef EN_MASK
#define EN_MASK 0x3FF
#endif
#define PHEN(n) ((((EN_MASK) >> (n)) & 1) && (sel_it < 0 || (sel_ph == (n) && (sel_it == it_))))
    if (PHEN(8)) run_phase<8>(0, lds, wave_s); GRID_BAR();
    for (int it = 0; it < 2 * DEPTH; ++it) { it_ = it;
        if (PHEN(0)) run_phase<0>(it, lds, wave_s); GRID_BAR();
        if (PHEN(1)) run_phase<1>(it, lds, wave_s); GRID_BAR();
        if (PHEN(2)) run_phase<2>(it, lds, wave_s); GRID_BAR();
        if ((it & 1) == 0) {
            if (PHEN(3)) run_phase<3>(it, lds, wave_s); GRID_BAR();
            if (PHEN(4)) run_phase<4>(it, lds, wave_s); GRID_BAR();
            if (PHEN(5)) run_phase<5>(it, lds, wave_s); GRID_BAR();
            if (PHEN(6)) run_phase<6>(it, lds, wave_s); GRID_BAR();
            if (PHEN(7)) run_phase<7>(it, lds, wave_s); GRID_BAR();
        }
    }
    it_ = 0;
    if (PHEN(9)) run_phase<9>(0, lds, wave_s);
#undef GRID_BAR
}

template <int PH> static void launch_phase(Params p, int it, int grid, hipStream_t stream) {
    static bool attr_set = false;
    if (!attr_set) { (void)hipFuncSetAttribute((const void*)phase_kernel<PH>, hipFuncAttributeMaxDynamicSharedMemorySize, LDS_BYTES); attr_set = true; }
    p.one_it = it; p.one_ph = PH;
    hipLaunchKernelGGL(phase_kernel<PH>, dim3(grid), dim3(NWAVES * 64), LDS_BYTES, stream, p);
}
extern "C" void kernel_launch(void* const* d_in, const int* in_sizes, int n_in, void* d_out, int out_size, void* d_ws, size_t ws_size, hipStream_t stream) {
    static int grid = 0;
    if (grid == 0) {
        if (n_in != 15 || in_sizes[0] != MTOK * DM || out_size != MTOK * DM || ws_size < WS_END) {
            fprintf(stderr, "kernel_launch: unexpected shapes (n_in %d, in0 %d, out %d, ws %zu, need %zu); nothing launched\n", n_in, n_in > 0 ? in_sizes[0] : -1, out_size, ws_size, (size_t)WS_END); grid = -1; return; }
        int dev = 0, cus = 0, per_cu = 0;
        if (hipGetDevice(&dev) != hipSuccess || hipDeviceGetAttribute(&cus, hipDeviceAttributeMultiprocessorCount, dev) != hipSuccess) { fprintf(stderr, "kernel_launch: device query failed\n"); grid = -1; return; }
        if (hipFuncSetAttribute((const void*)mega_fwd, hipFuncAttributeMaxDynamicSharedMemorySize, LDS_BYTES) != hipSuccess) { fprintf(stderr, "kernel_launch: hipFuncSetAttribute failed\n"); grid = -1; return; }
        if (hipOccupancyMaxActiveBlocksPerMultiprocessor(&per_cu, (const void*)mega_fwd, NWAVES * 64, LDS_BYTES) != hipSuccess || per_cu < 1)
            fprintf(stderr, "kernel_launch: note: occupancy query reports %d workgroups per CU\n", per_cu);
        (void)hipGetLastError();
        grid = cus;
    }
    if (grid < 0) return;
    if (hipMemsetAsync((char*)d_ws + WS_CTL, 0, CTL_ZERO_BYTES, stream) != hipSuccess) { fprintf(stderr, "kernel_launch: memset failed\n"); return; }
    Params p{};
    p.x = (const float*)d_in[0]; p.c = (const float*)d_in[1]; p.w_ada = (const float*)d_in[2]; p.b_ada = (const float*)d_in[3]; p.norm_g = (const float*)d_in[4];
    p.w_gu = (const float*)d_in[5]; p.w_d = (const float*)d_in[6]; p.w_in = (const float*)d_in[7]; p.w_o = (const float*)d_in[8]; p.diff_lam = (const float*)d_in[9];
    p.diff_subln = (const float*)d_in[10]; p.cmp_pe = (const float*)d_in[11]; p.cmp_w1 = (const float*)d_in[12]; p.cmp_w2 = (const float*)d_in[13]; p.final_g = (const float*)d_in[14];
    p.out = (float*)d_out; p.ws = (unsigned char*)d_ws;
#if MK_MULTI == 2
    auto lm = [&](int it, int ph) { p.one_it = it; p.one_ph = ph; hipLaunchKernelGGL(mega_fwd, dim3(grid), dim3(NWAVES * 64), LDS_BYTES, stream, p); };
    lm(0, 8);
    for (int it = 0; it < 2 * DEPTH; ++it) { const int nph = (it & 1) ? 3 : 8; for (int ph = 0; ph < nph; ++ph) { lm(it, ph);
#ifdef REPEAT_MASK
        if ((REPEAT_MASK >> ph) & 1) lm(it, ph);
#endif
    } }
    lm(0, 9);
#elif MK_MULTI
    launch_phase<8>(p, 0, grid, stream);
#ifdef REPEAT_PRO
    launch_phase<8>(p, 0, grid, stream);
#endif
    for (int it = 0; it < 2 * DEPTH; ++it) {
        launch_phase<0>(p, it, grid, stream); launch_phase<1>(p, it, grid, stream); launch_phase<2>(p, it, grid, stream);
        if ((it & 1) == 0) { launch_phase<3>(p, it, grid, stream); launch_phase<4>(p, it, grid, stream); launch_phase<5>(p, it, grid, stream); launch_phase<6>(p, it, grid, stream);
#ifdef REPEAT_ATTN
            launch_phase<5>(p, it, grid, stream); launch_phase<6>(p, it, grid, stream);
#endif
 launch_phase<7>(p, it, grid, stream); }
    }
    launch_phase<9>(p, 0, grid, stream);
#else
    p.one_it = -1; p.one_ph = 0;
    hipLaunchKernelGGL(mega_fwd, dim3(grid), dim3(NWAVES * 64), LDS_BYTES, stream, p);
#endif
    const hipError_t le = hipPeekAtLastError();
    if (le != hipSuccess) fprintf(stderr, "kernel_launch: launch failed: %s\n", hipGetErrorName(le));
}
```

```cpp
#include <hip/hip_runtime.h>
#include <hip/hip_bf16.h>
#include <cstdio>
#include <cstdint>
namespace pg8 {
#define PG8_LAS __attribute__((address_space(3)))
typedef unsigned short bf16_t;
typedef short bf16x8 __attribute__((ext_vector_type(8)));
typedef float f32x4 __attribute__((ext_vector_type(4)));
typedef unsigned u32x4 __attribute__((ext_vector_type(4)));
constexpr int BM = 256, BK = 64, HALF = 128, HTB = HALF * BK * 2  , STAGE_BYTES = 8 * HTB, NXCD = 8, WGM = 8;

__host__ __device__ __forceinline__ int lds_byte(int r, int c) { const int st = (r >> 4) * 2 + (c >> 5), rr = r & 15, cc = c & 31, ob = rr * 64 + cc * 2; return st * 1024 + (ob ^ (((ob >> 9) & 1) << 5)); }
__host__ __device__ __forceinline__ void stage_rc(int b, int& R, int& C) { const int st = b / 1024, sb = b % 1024, swz = sb ^ (((sb >> 9) & 1) << 5); R = (st >> 1) * 16 + swz / 64; C = (st & 1) * 32 + (swz % 64) / 2; }
__host__ __device__ __forceinline__ int perm32(int rho) { const int n = rho >> 4, i = rho & 15; return 8 * (i >> 2) + 4 * n + (i & 3); }

struct Unit { int pm, pn; };
struct Gemm { const bf16_t* A; const bf16_t* Bt; int M, N, K; };

struct StaticOrder {
    int nM, nN, nwg, G, c;
    __host__ __device__ void init(int M, int N, int G_, int c_) { nM = M / BM; nN = N / BM; nwg = nM * nN; G = G_; c = c_; }
    __host__ __device__ bool next(int i, Unit& u) const {
        const long L = (long)i * G + c; if (L >= nwg) return false;
        int wgid = (int)L; { const int q = nwg / NXCD, r = nwg % NXCD, xcd = wgid % NXCD, off = wgid / NXCD; wgid = (xcd < r ? xcd * (q + 1) : r * (q + 1) + (xcd - r) * q) + off; }
        const int nig = WGM * nN, gid = wgid / nig, fm = gid * WGM, gsz = (nM - fm) < WGM ? (nM - fm) : WGM;
        u.pm = fm + ((wgid % nig) % gsz); u.pn = (wgid % nig) / gsz; return true;
    }
    __device__ __forceinline__ void a_ready(const Unit&) const {}
    __device__ __forceinline__ void done(const Unit&) const {}
};

__device__ __forceinline__ unsigned cvt_pk_bf16(float lo, float hi) { unsigned r; asm volatile("v_cvt_pk_bf16_f32 %0, %1, %2" : "=v"(r) : "v"(lo), "v"(hi)); return r; }
typedef float f32x2 __attribute__((ext_vector_type(2)));
typedef float f32x2_t __attribute__((ext_vector_type(2))); typedef __bf16 bf16x2_t __attribute__((ext_vector_type(2)));
__device__ __forceinline__ unsigned cvtpk(float lo, float hi) { f32x2_t v = {lo, hi}; bf16x2_t b = __builtin_convertvector(v, bf16x2_t); return __builtin_bit_cast(unsigned, b); }
__host__ __device__ __forceinline__ int swap23(int r) { return (r & ~12) | ((r & 4) << 1) | ((r & 8) >> 1); }
__device__ __forceinline__ float silu_f(float g) { return g * __builtin_amdgcn_rcpf(1.0f + __builtin_amdgcn_exp2f(-1.4426950408889634f * g)); }
__device__ __forceinline__ float sigmoid_f(float g) { return __builtin_amdgcn_rcpf(1.0f + __builtin_amdgcn_exp2f(-1.4426950408889634f * g)); }

template <int K> __device__ __forceinline__ float shx(float v) {
    if constexpr (K < 32) return __builtin_bit_cast(float, __builtin_amdgcn_ds_swizzle(__builtin_bit_cast(int, v), (K << 10) | 0x1f));
    else { const unsigned u = __builtin_bit_cast(unsigned, v); auto rr = __builtin_amdgcn_permlane32_swap(u, u, false, false);
        unsigned lo; asm volatile("v_mbcnt_lo_u32_b32 %0, -1, 0" : "=v"(lo));
        return __builtin_bit_cast(float, lo >= 32u ? rr[0] : rr[1]); }
}
template <int K> __device__ __forceinline__ unsigned shxu(unsigned v) { return __builtin_bit_cast(unsigned, shx<K>(__builtin_bit_cast(float, v))); }
struct EpiSwiglu {
    static constexpr bool PERM = true, AFTER_DRAIN = false;
    bf16_t* act; int ldc;
    __device__ __forceinline__ void operator()(const f32x4 (&acc)[2][2][4][2], const Unit& u, int wr, int wc, int fr, int fq) const {
        const int row0 = u.pm * BM + wr * 64 + fr, col0 = u.pn * 128 + wc * 32 + 8 * fq;
#pragma unroll
        for (int ai = 0; ai < 2; ++ai)
#pragma unroll
            for (int m = 0; m < 4; ++m) {
                bf16_t* rowp = act + (size_t)(row0 + ai * HALF + m * 16) * ldc + col0;
                const f32x4 g0 = acc[ai][0][m][0], g1 = acc[ai][0][m][1], u0 = acc[ai][1][m][0], u1 = acc[ai][1][m][1];
                u32x4 w;
                w.x = cvtpk(silu_f(g0[0]) * u0[0], silu_f(g0[1]) * u0[1]); w.y = cvtpk(silu_f(g0[2]) * u0[2], silu_f(g0[3]) * u0[3]);
                w.z = cvtpk(silu_f(g1[0]) * u1[0], silu_f(g1[1]) * u1[1]); w.w = cvtpk(silu_f(g1[2]) * u1[2], silu_f(g1[3]) * u1[3]);
                *(u32x4*)rowp = w;
            }
    }
};
struct EpiResid {
    static constexpr bool PERM = false, AFTER_DRAIN = false;
    float* x; const float* gate; int gstride; float coef;
    __device__ __forceinline__ void operator()(const f32x4 (&acc)[2][2][4][2], const Unit& u, int wr, int wc, int fr, int fq) const {
        const int row0 = u.pm * BM + wr * 64 + fr, col0 = u.pn * BM + wc * 32 + 4 * fq;
        const float* gp = gate + (size_t)(u.pm >> 4) * gstride;
#pragma unroll
        for (int bj = 0; bj < 2; ++bj)
#pragma unroll
            for (int n = 0; n < 2; ++n) {
                const int col = col0 + bj * HALF + n * 16;
                const f32x4 gv = *(const f32x4*)(gp + col) * coef;
#pragma unroll
                for (int ai = 0; ai < 2; ++ai)
#pragma unroll
                    for (int m = 0; m < 4; ++m) {
                        float* p = x + (size_t)(row0 + ai * HALF + m * 16) * 2048 + col;
                        const f32x4 xv = *(const f32x4*)p;
                        *(f32x4*)p = xv + gv * acc[ai][bj][m][n];
                    }
            }
    }
};
struct EpiVT {
    static constexpr bool PERM = true, AFTER_DRAIN = false;
    bf16_t* vtt;
    __device__ __forceinline__ void operator()(const f32x4 (&acc)[2][2][4][2], const Unit& u, int wr, int wc, int fr, int fq) const {
#pragma unroll
        for (int ai = 0; ai < 2; ++ai)
#pragma unroll
            for (int m = 0; m < 4; ++m) {
                const int row = u.pm * BM + ai * HALF + wr * 64 + m * 16 + fr, slot = row >> 7, dt = (row >> 5) & 3, d = row & 31;
#pragma unroll
                for (int bj = 0; bj < 2; ++bj) {
                    const int tc = 32 * u.pn + 16 * bj + 4 * wc + fq, T = tc >> 2, s = (tc >> 1) & 1, h2 = tc & 1;
                    const f32x4 v0 = acc[ai][bj][m][0], v1 = acc[ai][bj][m][1];
                    u32x4 w; w.x = cvtpk(v0[0], v0[1]); w.y = cvtpk(v0[2], v0[3]); w.z = cvtpk(v1[0], v1[1]); w.w = cvtpk(v1[2], v1[3]);
                    *(u32x4*)(vtt + ((size_t)((((slot * 4 + dt) * 256 + T) * 2 + s) * 64 + h2 * 32 + d)) * 8) = w;
                }
            }
    }
};
struct EpiNat {
    static constexpr bool PERM = true, AFTER_DRAIN = false;
    bf16_t* nat; float* gates; const float* rope; float qs_d, qs_n;
    __device__ __forceinline__ void operator()(const f32x4 (&acc)[2][2][4][2], const Unit& u, int wr, int wc, int fr, int fq) const {
        asm volatile("" : "+v"(fr), "+v"(fq));
#pragma unroll
        for (int bj = 0; bj < 2; ++bj) {
            const int slot = 2 * u.pn + bj;
            if (slot >= 33) continue;
            const bool r64 = slot < 16, r128 = (slot >= 16 && slot < 24) || (slot >= 28 && slot < 32);
            const bool ktype = (slot >= 8 && slot < 16) || (slot >= 28 && slot < 32);
            const float sc = slot < 8 ? qs_d : ((slot >= 16 && slot < 24) ? qs_n : 1.0f);
#pragma unroll
            for (int ai = 0; ai < 2; ++ai)
#pragma unroll
                for (int m = 0; m < 4; ++m) {
                    const int row = u.pm * BM + ai * HALF + wr * 64 + m * 16 + fr, b = row >> 12, t = row & 4095;
                    float v[8];
#pragma unroll
                    for (int e = 0; e < 4; ++e) { v[e] = acc[ai][bj][m][0][e]; v[4 + e] = acc[ai][bj][m][1][e]; }
                    if (slot == 32) {
                        if (wc == 0 && fq < 3) {
                            float* gp = gates + (size_t)row * 24 + 8 * fq;
                            *(f32x4*)gp = (f32x4){sigmoid_f(v[0]), sigmoid_f(v[1]), sigmoid_f(v[2]), sigmoid_f(v[3])};
                            *(f32x4*)(gp + 4) = (f32x4){sigmoid_f(v[4]), sigmoid_f(v[5]), sigmoid_f(v[6]), sigmoid_f(v[7])};
                        }
                        continue;
                    }
                    const float* rp = rope + (size_t)t * 48;
                    if (r64 && (wc & 1) == 0) {
                        const f32x4 c0 = *(const f32x4*)(rp), c1 = *(const f32x4*)(rp + 4), s0 = *(const f32x4*)(rp + 8), s1 = *(const f32x4*)(rp + 12);
#pragma unroll
                        for (int e = 0; e < 8; ++e) {
                            const float pv = shx<16>(v[e]), cs = e < 4 ? c0[e & 3] : c1[e & 3], sn = e < 4 ? s0[e & 3] : s1[e & 3];
                            const float rot = fq == 0 ? v[e] * cs - pv * sn : v[e] * cs + pv * sn;
                            v[e] = fq < 2 ? rot : v[e];
                        }
                    }
                    if (r128 && wc == 0) {
                        const float* cp = rp + 16 + 8 * (fq & 1); const float* sp = rp + 32 + 8 * (fq & 1);
                        const f32x4 c0 = *(const f32x4*)(cp), c1 = *(const f32x4*)(cp + 4), s0 = *(const f32x4*)(sp), s1 = *(const f32x4*)(sp + 4);
#pragma unroll
                        for (int e = 0; e < 8; ++e) {
                            const float pv = shx<32>(v[e]), cs = e < 4 ? c0[e & 3] : c1[e & 3], sn = e < 4 ? s0[e & 3] : s1[e & 3];
                            v[e] = fq < 2 ? v[e] * cs - pv * sn : v[e] * cs + pv * sn;
                        }
                    }
                    u32x4 w; w.x = cvtpk(v[0] * sc, v[1] * sc); w.y = cvtpk(v[2] * sc, v[3] * sc); w.z = cvtpk(v[4] * sc, v[5] * sc); w.w = cvtpk(v[6] * sc, v[7] * sc);
                    const int dc = 4 * wc + fq;
                    bf16_t* base = nat + (size_t)(slot * 2 + b) * (4096 * 128);
                    if (slot >= 24 && slot < 28) *(u32x4*)(base + (size_t)t * 128 + dc * 8) = w;
                    else { const int rp2 = ktype ? swap23(t & 31) : (t & 31);
                        *(u32x4*)(base + ((size_t)(((t >> 5) * 8 + (dc >> 1)) * 64 + (dc & 1) * 32 + rp2)) * 8) = w; }
                }
        }
    }
};
template <class Epi, class Sched, bool ALIGN_EPI = false, bool SP2 = false>
__device__ __forceinline__ void gemm_phase(PG8_LAS unsigned char* lds, const Gemm g, const Sched& S, const Epi& E, int tid0_) {
    asm volatile("" : "+v"(tid0_));
    const int tid = tid0_, wid = __builtin_amdgcn_readfirstlane(tid >> 6), lane = tid & 63, wr = wid >> 2, wc = wid & 3, fr = lane & 15, fq = lane >> 4;
    const int K = g.K, nt = K / BK;
    unsigned voffA[2], voffB[2];
#pragma unroll
    for (int i = 0; i < 2; ++i) { int R, C; stage_rc(tid * 16 + i * 8192, R, C); const int Rb = Epi::PERM ? ((R & ~31) + perm32(R & 31)) : R;
        voffA[i] = (unsigned)(R * K + C) * 2u; voffB[i] = (unsigned)(Rb * K + C) * 2u; }
    const size_t kstep = (size_t)(BK * 2);
    const size_t hstep = (size_t)HALF * K * 2;
    const size_t tstep = 2 * hstep;
    const unsigned ldsw = (unsigned)wid * 1024u;
    const int aoff = lds_byte(wr * 64 + fr, fq * 8), boff = lds_byte(wc * 32 + fr, fq * 8);
#define PG8_SA(b, h) (((b) * 2 + (h)) * HTB)
#define PG8_SB(b, h) ((4 + (b) * 2 + (h)) * HTB)
#define PG8_STAGE(bufoff, gbase, voff) do { _Pragma("unroll") for (int _i = 0; _i < 2; ++_i) \
        __builtin_amdgcn_global_load_lds((const unsigned*)((const char*)(gbase) + (voff)[_i]), (PG8_LAS unsigned*)(lds + (bufoff) + ldsw + _i * 8192), 16, 0, 0); } while (0)
#define PG8_LDA(dst, b, h) do { _Pragma("unroll") for (int m = 0; m < 4; ++m) _Pragma("unroll") for (int k = 0; k < 2; ++k) dst[m][k] = *(const PG8_LAS bf16x8*)(lds + PG8_SA(b, h) + aoff + m * 2048 + k * 1024); } while (0)
#define PG8_LDB(dst, b, h) do { _Pragma("unroll") for (int n = 0; n < 2; ++n) _Pragma("unroll") for (int k = 0; k < 2; ++k) dst[n][k] = *(const PG8_LAS bf16x8*)(lds + PG8_SB(b, h) + boff + n * 2048 + k * 1024); } while (0)
#define PG8_MMA(ai, bj, At, Bt) do { __builtin_amdgcn_s_setprio(1); _Pragma("unroll") for (int m = 0; m < 4; ++m) _Pragma("unroll") for (int n = 0; n < 2; ++n) _Pragma("unroll") for (int k = 0; k < 2; ++k) \
        acc[ai][bj][m][n] = __builtin_amdgcn_mfma_f32_16x16x32_bf16(Bt[n][k], At[m][k], acc[ai][bj][m][n], 0, 0, 0); __builtin_amdgcn_s_setprio(0); } while (0)
#define PG8_WAIT_V(n) asm volatile("s_waitcnt vmcnt(" #n ")" ::: "memory")
#define PG8_WAIT_L(n) asm volatile("s_waitcnt lgkmcnt(" #n ")" ::: "memory")
#define PG8_BAR __builtin_amdgcn_s_barrier()
#define PG8_SCHED __builtin_amdgcn_sched_barrier(0)
    Unit cur, nxt; int ui = 0;
    if (!S.next(0, cur)) return;
    f32x4 acc[2][2][4][2];
#pragma unroll
    for (int a = 0; a < 2; ++a)
#pragma unroll
        for (int b = 0; b < 2; ++b)
#pragma unroll
            for (int m = 0; m < 4; ++m)
#pragma unroll
                for (int n = 0; n < 2; ++n) acc[a][b][m][n] = (f32x4){0.f, 0.f, 0.f, 0.f};
    bf16x8 At[4][2], B0[2][2], B1[2][2];
    const char* cA = (const char*)g.A + (size_t)cur.pm * tstep; const char* cB = (const char*)g.Bt + (size_t)cur.pn * tstep;
    S.a_ready(cur);
    if constexpr (SP2) {
        PG8_STAGE(PG8_SB(0, 0), cB, voffB); PG8_STAGE(PG8_SB(0, 1), cB + hstep, voffB); PG8_STAGE(PG8_SA(0, 0), cA, voffA); PG8_STAGE(PG8_SA(0, 1), cA + hstep, voffA);
        if (wr == 1) PG8_BAR;
        PG8_WAIT_V(2); PG8_BAR;
        PG8_STAGE(PG8_SB(1, 0), cB + kstep, voffB); PG8_STAGE(PG8_SA(1, 0), cA + kstep, voffA); PG8_STAGE(PG8_SB(1, 1), cB + hstep + kstep, voffB);
        PG8_WAIT_V(6); PG8_BAR;
    } else {
        PG8_STAGE(PG8_SB(0, 0), cB, voffB); PG8_STAGE(PG8_SA(0, 0), cA, voffA); PG8_STAGE(PG8_SB(0, 1), cB + hstep, voffB); PG8_STAGE(PG8_SA(0, 1), cA + hstep, voffA);
        if (wr == 1) PG8_BAR;
        PG8_WAIT_V(4); PG8_BAR;
        PG8_STAGE(PG8_SB(1, 0), cB + kstep, voffB); PG8_STAGE(PG8_SA(1, 0), cA + kstep, voffA); PG8_STAGE(PG8_SB(1, 1), cB + hstep + kstep, voffB);
        PG8_WAIT_V(6); PG8_BAR;
    }
    for (;;) {
        const bool has_next = S.next(ui + 1, nxt);
        const char* nA = has_next ? (const char*)g.A + (size_t)nxt.pm * tstep : cA; const char* nB = has_next ? (const char*)g.Bt + (size_t)nxt.pn * tstep : cB;
        for (int t = 0; t < nt; t += 2) {
            const bool last = (t == nt - 2);
            const char* a1 = cA + (size_t)(t + 1) * kstep;
            const char* a2 = last ? nA : cA + (size_t)(t + 2) * kstep; const char* b2 = last ? nB : cB + (size_t)(t + 2) * kstep;
            const char* a3 = a2 + kstep; const char* b3 = b2 + kstep;
            if (last && has_next) S.a_ready(nxt);
            if constexpr (SP2) {
            PG8_LDB(B0, 0, 0); PG8_LDB(B1, 0, 1); PG8_SCHED; PG8_LDA(At, 0, 0); PG8_STAGE(PG8_SA(1, 1), a1 + hstep, voffA);
            PG8_WAIT_V(8); PG8_WAIT_L(0); PG8_BAR; PG8_MMA(0, 0, At, B0); PG8_MMA(0, 1, At, B1); PG8_BAR; PG8_SCHED;
            PG8_LDA(At, 0, 1); PG8_STAGE(PG8_SB(0, 0), b2, voffB); PG8_STAGE(PG8_SB(0, 1), b2 + hstep, voffB); PG8_STAGE(PG8_SA(0, 0), a2, voffA);
            PG8_WAIT_V(8); PG8_WAIT_L(0); PG8_BAR; PG8_MMA(1, 0, At, B0); PG8_MMA(1, 1, At, B1); PG8_BAR; PG8_SCHED;
            PG8_LDB(B0, 1, 0); PG8_LDB(B1, 1, 1); PG8_SCHED; PG8_LDA(At, 1, 0); PG8_STAGE(PG8_SA(0, 1), a2 + hstep, voffA);
            PG8_WAIT_V(8); PG8_WAIT_L(0); PG8_BAR; PG8_MMA(0, 0, At, B0); PG8_MMA(0, 1, At, B1); PG8_BAR; PG8_SCHED;
            PG8_LDA(At, 1, 1); PG8_STAGE(PG8_SB(1, 0), b3, voffB); PG8_STAGE(PG8_SB(1, 1), b3 + hstep, voffB); PG8_STAGE(PG8_SA(1, 0), a3, voffA);
            PG8_WAIT_V(8); PG8_WAIT_L(0); PG8_BAR; PG8_MMA(1, 0, At, B0); PG8_MMA(1, 1, At, B1); PG8_BAR; PG8_SCHED;
            } else {
            PG8_LDB(B0, 0, 0); PG8_SCHED; PG8_LDA(At, 0, 0); PG8_STAGE(PG8_SA(1, 1), a1 + hstep, voffA);
            PG8_WAIT_L(8); PG8_BAR; PG8_WAIT_L(0); PG8_MMA(0, 0, At, B0); PG8_BAR; PG8_SCHED;
            PG8_LDB(B1, 0, 1); PG8_STAGE(PG8_SB(0, 0), b2, voffB);
            PG8_BAR; PG8_WAIT_L(0); PG8_MMA(0, 1, At, B1); PG8_BAR;
            PG8_LDA(At, 0, 1); PG8_STAGE(PG8_SA(0, 0), a2, voffA);
            PG8_BAR; PG8_WAIT_L(0); PG8_MMA(1, 0, At, B0); PG8_BAR; PG8_SCHED;
            PG8_STAGE(PG8_SB(0, 1), b2 + hstep, voffB);
            PG8_WAIT_V(6); PG8_BAR; PG8_MMA(1, 1, At, B1); PG8_BAR;
            PG8_LDB(B0, 1, 0); PG8_SCHED; PG8_LDA(At, 1, 0); PG8_STAGE(PG8_SA(0, 1), a2 + hstep, voffA);
            PG8_WAIT_L(8); PG8_BAR; PG8_WAIT_L(0); PG8_MMA(0, 0, At, B0); PG8_BAR; PG8_SCHED;
            PG8_LDB(B1, 1, 1); PG8_STAGE(PG8_SB(1, 0), b3, voffB);
            PG8_BAR; PG8_WAIT_L(0); PG8_MMA(0, 1, At, B1); PG8_BAR;
            PG8_LDA(At, 1, 1); PG8_STAGE(PG8_SA(1, 0), a3, voffA);
            PG8_BAR; PG8_WAIT_L(0); PG8_MMA(1, 0, At, B0); PG8_BAR; PG8_SCHED;
            PG8_STAGE(PG8_SB(1, 1), b3 + hstep, voffB);
            PG8_WAIT_V(6); PG8_BAR; PG8_MMA(1, 1, At, B1); PG8_BAR;
            }
        }
        if constexpr (ALIGN_EPI) { if (wr == 0) PG8_BAR; }
        if constexpr (!Epi::AFTER_DRAIN) { E(acc, cur, wr, wc, fr, fq); S.done(cur); }
        if (!has_next) break;
#pragma unroll
        for (int a = 0; a < 2; ++a)
#pragma unroll
            for (int b = 0; b < 2; ++b)
#pragma unroll
                for (int m = 0; m < 4; ++m)
#pragma unroll
                    for (int n = 0; n < 2; ++n) acc[a][b][m][n] = (f32x4){0.f, 0.f, 0.f, 0.f};
        cur = nxt; cA = nA; cB = nB; ++ui;
        if constexpr (ALIGN_EPI) { if (wr == 1) PG8_BAR; }
    }
    PG8_WAIT_V(0);
    if constexpr (!ALIGN_EPI) { if (wr == 0) PG8_BAR; }
    PG8_BAR;
    if constexpr (Epi::AFTER_DRAIN) { E.fused(acc, cur, wr, wc, fr, fq, lds, wid, lane); S.done(cur); }
#undef PG8_SA
#undef PG8_SB
#undef PG8_STAGE
#undef PG8_LDA
#undef PG8_LDB
#undef PG8_MMA
#undef PG8_WAIT_V
#undef PG8_WAIT_L
#undef PG8_BAR
#undef PG8_SCHED
}
}
#ifndef PG8_SP2
#define PG8_SP2 true
#endif
#ifndef PG8_ALIGN
#define PG8_ALIGN true
#endif
constexpr int NWAVES = 8;
constexpr int BATCH = 2, SEQ = 4096, DM = 2048, MTOK = BATCH * SEQ, DEPTH = 4, DFF = 5632, NGU = 2 * DFF, INC = 5656;
constexpr int NATN = 4352, VTN = 1536, NMOD = 9;
constexpr float RMS_EPS = 1e-6f;
constexpr float LOG2E = 1.4426950408889634f;
#ifndef ATTN_V2
#define ATTN_V2 1
#endif
#ifndef MK_MULTI
#define MK_MULTI 0
#endif
constexpr size_t al256(size_t x) { return (x + 255) & ~(size_t)255; }
constexpr size_t WS_CTL = 0, CTL_ZERO_BYTES = 1u << 20;
constexpr size_t WS_MOD = CTL_ZERO_BYTES;
constexpr size_t WS_ROPE = al256(WS_MOD + (size_t)DEPTH * BATCH * NMOD * DM * 4);
constexpr size_t WS_BIAS1 = al256(WS_ROPE + (size_t)SEQ * 48 * 4);
constexpr size_t WS_LAM = al256(WS_BIAS1 + (size_t)DEPTH * 2 * 256 * 4);
constexpr size_t WS_WGU = al256(WS_LAM + 256);
constexpr size_t WS_WD = al256(WS_WGU + (size_t)DEPTH * 2 * NGU * DM * 2);
constexpr size_t WS_WNAT = al256(WS_WD + (size_t)DEPTH * 2 * DM * DFF * 2);
constexpr size_t WS_WV = al256(WS_WNAT + (size_t)DEPTH * NATN * DM * 2);
constexpr size_t WS_WO = al256(WS_WV + (size_t)DEPTH * VTN * DM * 2);
constexpr size_t WS_W1T = al256(WS_WO + (size_t)DEPTH * DM * DM * 2);
constexpr size_t WS_W2T = al256(WS_W1T + (size_t)DEPTH * 2 * 256 * 4096 * 2);
constexpr size_t WS_H = al256(WS_W2T + (size_t)DEPTH * 2 * 128 * 256 * 2);
constexpr size_t WS_ACT = al256(WS_H + (size_t)MTOK * DM * 2);
constexpr size_t WS_NAT = al256(WS_ACT + (size_t)MTOK * DFF * 2);
constexpr size_t WS_VTT = al256(WS_NAT + (size_t)32 * MTOK * 128 * 2);
constexpr size_t WS_KC = al256(WS_VTT + (size_t)VTN * MTOK * 2);
constexpr size_t WS_VCT = al256(WS_KC + (size_t)4 * 256 * 128 * 2);
constexpr size_t WS_GATES = al256(WS_VCT + (size_t)4 * 256 * 128 * 2);
constexpr size_t WS_OATT = al256(WS_GATES + (size_t)MTOK * 24 * 4);
constexpr size_t WS_SCR = al256(WS_OATT + (size_t)MTOK * DM * 2);
constexpr size_t WS_END = al256(WS_SCR + (size_t)512 * 8 * 4096 * 4);
constexpr int CW_BAR = 4096;
constexpr int RING_OFF = 0, RING_BYTES = 131072;
constexpr int LDSCTL_OFF = RING_BYTES, MISC_OFF = LDSCTL_OFF + 320;
constexpr int LDS_BYTES = 155648;

#define GAS __attribute__((address_space(1)))
#define LAS __attribute__((address_space(3)))
typedef unsigned short bf16;
typedef unsigned v4u __attribute__((ext_vector_type(4)));
typedef unsigned v2u __attribute__((ext_vector_type(2)));
typedef float f32x4 __attribute__((ext_vector_type(4)));
typedef float f32x16 __attribute__((ext_vector_type(16)));
typedef short bf16x8 __attribute__((ext_vector_type(8)));
typedef GAS unsigned gu32;
#define RLX_AGENT __ATOMIC_RELAXED, __HIP_MEMORY_SCOPE_AGENT
#define LDS_WAIT() asm volatile("s_waitcnt lgkmcnt(0)" ::: "memory")
using pg8::cvtpk; using pg8::swap23; using pg8::shx; using pg8::shxu;
__device__ __forceinline__ unsigned f2bf(float f) { unsigned u = __builtin_bit_cast(unsigned, f); return (u + 0x7fffu + ((u >> 16) & 1u)) >> 16; }
__device__ __forceinline__ unsigned pk2(float lo, float hi) { return f2bf(lo) | (f2bf(hi) << 16); }
__device__ __forceinline__ float ex2(float x) { return __builtin_amdgcn_exp2f(x); }
#define XB_TMO      128
#define XB_XCNT(j)  (256  + 64 * (j))
#define XB_XSUB(j)  (1280 + 64 * (j))
#define XB_XGEN(j)  (2304 + 64 * (j))
#define XB_TOP      3328
#define XB_TOPGEN   3392
#define XCD_BAR_WORDS 3456
#define XB_SPIN_CAP (1u << 18)

__device__ __forceinline__ unsigned xb_ld(unsigned* p)              { return __hip_atomic_load(p, __ATOMIC_RELAXED, __HIP_MEMORY_SCOPE_AGENT); }
__device__ __forceinline__ unsigned xb_add(unsigned* p, unsigned v) { return __hip_atomic_fetch_add(p, v, __ATOMIC_RELAXED, __HIP_MEMORY_SCOPE_AGENT); }
__device__ __forceinline__ unsigned xb_xcc_id() { return (unsigned)__builtin_amdgcn_s_getreg((3 << 11) | 20) & 0xFu; }
#define XB_SPIN(cond, bar) do { unsigned _sp = 0; while (cond) { __builtin_amdgcn_s_sleep(1); \
    if ((++_sp & 255u) == 0u) { if (xb_ld(&(bar)[XB_TMO])) break; if (_sp > XB_SPIN_CAP) { atomicAdd(&(bar)[XB_TMO], 1u); break; } } } } while (0)

struct XcdBarrier {
    unsigned* bar; unsigned x; bool t0;
    volatile LAS unsigned* st;
};

__device__ __forceinline__ XcdBarrier xcd_barrier_post(unsigned* bar, volatile LAS unsigned* st) {
    XcdBarrier b; b.bar = bar; b.x = xb_xcc_id(); b.st = st; b.t0 = (threadIdx.x == 0);
    if (threadIdx.x == 0) (void)xb_add(&bar[XB_XCNT(b.x)], 1u);
    return b;
}
__device__ __forceinline__ void xcd_barrier_complete(unsigned* bar, unsigned x, unsigned& nloc, unsigned& nx) {
    const unsigned G = gridDim.x * gridDim.y * gridDim.z;
    unsigned sum, cnt, mine, sp = 0u;
    for (;;) {
        sum = 0u; cnt = 0u; mine = 0u;
#pragma unroll
        for (unsigned j = 0; j < 16; ++j) { const unsigned c = xb_ld(&bar[XB_XCNT(j)]); sum += c; cnt += (c > 0u) ? 1u : 0u; mine = (j == x) ? c : mine; }
        if (sum == G) break;
        __builtin_amdgcn_s_sleep(1);
        if ((++sp & 255u) == 0u) { if (xb_ld(&bar[XB_TMO])) break; if (sp > XB_SPIN_CAP) { atomicAdd(&bar[XB_TMO], 1u); break; } }
    }
    nloc = mine > 0u ? mine : 1u; nx = cnt > 0u ? cnt : 1u;
}

__device__ __forceinline__ void xcd_barrier(const XcdBarrier& b) {
    asm volatile("s_waitcnt vmcnt(0)" ::: "memory");
    __syncthreads();
    if (b.t0) {
        unsigned* bar = b.bar;
        __builtin_amdgcn_s_waitcnt(0);
        unsigned nloc = b.st[0], nx = b.st[1];
        if (nloc == 0u) { xcd_barrier_complete(bar, b.x, nloc, nx); b.st[0] = nloc; b.st[1] = nx; }
        const unsigned old = xb_add(&bar[XB_XSUB(b.x)], 1u);
        const unsigned gen = old / nloc;
        if (old + 1u == (gen + 1u) * nloc) {
            __builtin_amdgcn_fence(__ATOMIC_RELEASE, "agent");
            asm volatile("s_waitcnt vmcnt(0)" ::: "memory");
            const unsigned og = xb_add(&bar[XB_TOP], 1u);
            const unsigned tg = og / nx;
            if (og + 1u == (tg + 1u) * nx) xb_add(&bar[XB_TOPGEN], 1u);
            else XB_SPIN(xb_ld(&bar[XB_TOPGEN]) == tg, bar);
            __builtin_amdgcn_fence(__ATOMIC_ACQUIRE, "agent");
            xb_add(&bar[XB_XGEN(b.x)], 1u);
            asm volatile("s_waitcnt vmcnt(0)" ::: "memory");
        } else {
            XB_SPIN(xb_ld(&bar[XB_XGEN(b.x)]) == gen, bar);
            __builtin_amdgcn_fence(__ATOMIC_ACQUIRE, "agent");
            asm volatile("s_waitcnt vmcnt(0)" ::: "memory");
        }
    }
    __syncthreads();
}
struct Params {
    const float *x, *c, *w_ada, *b_ada, *norm_g, *w_gu, *w_d, *w_in, *w_o, *diff_lam, *diff_subln, *cmp_pe, *cmp_w1, *cmp_w2, *final_g;
    float* out; unsigned char* ws; int one_it, one_ph;
};
__device__ __forceinline__ float wave_sum(float v) {
    v += shx<1>(v); v += shx<2>(v); v += shx<4>(v); v += shx<8>(v); v += shx<16>(v); v += shx<32>(v);
    return v;
}
__device__ __forceinline__ void transpose_item(const float* W, size_t ldw, int K, int k0, int n0, bf16* WT, int dst_row, LAS float* scr, int lane) {
#pragma unroll 8
    for (int i = 0; i < 32; ++i) { const int kk = 2 * i + (lane >> 5); scr[kk * 33 + (lane & 31)] = W[(size_t)(k0 + kk) * ldw + n0 + (lane & 31)]; }
    LDS_WAIT(); asm volatile("" ::: "memory");
    const int c = lane & 7;
#pragma unroll
    for (int j = 0; j < 4; ++j) { const int n = (lane >> 3) + 8 * j; const LAS float* s = scr + (8 * c) * 33 + n;
        v4u o; o.x = pk2(s[0 * 33], s[1 * 33]); o.y = pk2(s[2 * 33], s[3 * 33]); o.z = pk2(s[4 * 33], s[5 * 33]); o.w = pk2(s[6 * 33], s[7 * 33]);
        *(v4u*)(WT + (size_t)(dst_row + n) * K + k0 + 8 * c) = o; }
    LDS_WAIT(); asm volatile("" ::: "memory");
}
__device__ __forceinline__ void transpose_cols(const float* W, size_t ldw, int K, int ncols, int map, bf16* WT, int dst0, LAS float* scr, int gw, int NGW, int lane) {
    const int nblk = ncols / 32, nitems = (K / 64) * nblk;
    for (int it = gw; it < nitems; it += NGW) {
        const int kb = it / nblk, nb = it % nblk, n0 = nb * 32;
        int dr = dst0 + n0;
        if (map == 1) { const int n = n0 < DFF ? n0 : n0 - DFF; dr = 256 * (n >> 7) + (n & 127) + (n0 < DFF ? 0 : 128); }
        transpose_item(W, ldw, K, kb * 64, n0, WT, dr, scr, lane);
    }
}
template <int NB, bool SILU>
__device__ __forceinline__ void gemv_unit(const float* W, size_t ldw, int K, const float* vec, size_t vstride, float* out, size_t ostride, const float* bias, LAS unsigned char* lds, int tid, int wave, int lane) {
    LAS float* vs = (LAS float*)lds;
    LAS float* part = (LAS float*)(lds + 32768);
    for (int i = tid; i < NB * K; i += NWAVES * 64) { const int b = i / K, k = i % K; float v = vec[(size_t)b * vstride + k]; if (SILU) v = v / (1.0f + __expf(-v)); vs[i] = v; }
    __syncthreads();
    f32x4 acc[NB];
#pragma unroll
    for (int b = 0; b < NB; ++b) acc[b] = (f32x4){0.f, 0.f, 0.f, 0.f};
    const int kc = K / NWAVES, kbeg = wave * kc;
    const float* wp = W + (size_t)kbeg * ldw + 4 * lane;
#pragma unroll 8
    for (int k = 0; k < kc; ++k) { const f32x4 wv = *(const f32x4*)(wp + (size_t)k * ldw);
#pragma unroll
        for (int b = 0; b < NB; ++b) acc[b] += vs[b * K + kbeg + k] * wv; }
#pragma unroll
    for (int b = 0; b < NB; ++b) *(LAS f32x4*)(part + (wave * NB + b) * 256 + 4 * lane) = acc[b];
    __syncthreads();
    if (tid < NB * 256) { const int b = tid >> 8, n = tid & 255; float s = bias ? bias[n] : 0.f;
#pragma unroll
        for (int w = 0; w < NWAVES; ++w) s += part[(w * NB + b) * 256 + n];
        out[(size_t)b * ostride + n] = s; }
    __syncthreads();
}
__device__ __forceinline__ void prologue(const Params& p, LAS unsigned char* lds, int bid, int G, int tid, int wave, int lane) {
    unsigned char* ws = p.ws;
    const int gw = bid * NWAVES + wave, NGW = G * NWAVES;
    for (int u = bid; u < 288 + 8; u += G) {
        if (u < 288) { const int l = u / 72, n0 = (u % 72) * 256;
            gemv_unit<2, true>(p.w_ada + (size_t)l * DM * (NMOD * DM) + n0, (size_t)NMOD * DM, DM, p.c, DM, (float*)(ws + WS_MOD) + (size_t)l * 2 * NMOD * DM + n0, (size_t)NMOD * DM, p.b_ada + (size_t)l * NMOD * DM + n0, lds, tid, wave, lane);
        } else { const int lj = u - 288;
            gemv_unit<1, false>(p.cmp_w1 + (size_t)lj * 4096 * 256, 256, 4096, p.cmp_pe + (size_t)lj * 4096, 0, (float*)(ws + WS_BIAS1) + lj * 256, 0, nullptr, lds, tid, wave, lane);
        }
    }
    { const f32x4* s = (const f32x4*)p.x; f32x4* d = (f32x4*)p.out; const size_t n4 = (size_t)MTOK * DM / 4;
      for (size_t i = (size_t)bid * (NWAVES * 64) + tid; i < n4; i += (size_t)G * (NWAVES * 64)) d[i] = s[i]; }
    { float* rp = (float*)(ws + WS_ROPE);
      for (int i = bid * (NWAVES * 64) + tid; i < SEQ * 24; i += G * (NWAVES * 64)) { const int t = i / 24, k = i % 24;
          const int half = k < 8 ? 8 : 16, ii = k < 8 ? k : k - 8;
          const float inv = expf((-13.122363377404328f * (float)ii) / (float)half), ang = (float)t * inv;
          const float cs = cosf(ang), sn = sinf(ang);
          if (k < 8) { rp[t * 48 + ii] = cs; rp[t * 48 + 8 + ii] = sn; } else { rp[t * 48 + 16 + ii] = cs; rp[t * 48 + 32 + ii] = sn; } } }
    if (bid == 0 && tid < DEPTH) { const float* lf = p.diff_lam + tid * 4 * 64; float s01 = 0.f, s23 = 0.f;
        for (int i = 0; i < 64; ++i) { s01 += lf[i] * lf[64 + i]; s23 += lf[128 + i] * lf[192 + i]; }
        const float li = 0.8f - 0.6f * expf(-0.3f * (float)tid);
        float* o = (float*)(ws + WS_LAM) + tid * 2; o[0] = expf(s01) - expf(s23) + li; o[1] = 1.0f - li; }
    for (int i = bid * (NWAVES * 64) + tid; i < DEPTH * 24 * DM; i += G * (NWAVES * 64)) { const int l = i / (24 * DM), r = i % (24 * DM), cidx = r / DM, k = r % DM;
        ((bf16*)(ws + WS_WNAT))[((size_t)l * NATN + 4096 + cidx) * DM + k] = (bf16)f2bf(p.w_in[((size_t)l * DM + k) * INC + 5632 + cidx]); }
    LAS float* scr = (LAS float*)(lds + wave * 16384);
    for (int l = 0; l < DEPTH; ++l) {
        for (int f = 0; f < 2; ++f) {
            transpose_cols(p.w_gu + (size_t)(l * 2 + f) * DM * NGU, NGU, DM, NGU, 1, (bf16*)(ws + WS_WGU) + (size_t)(l * 2 + f) * NGU * DM, 0, scr, gw, NGW, lane);
            transpose_cols(p.w_d + (size_t)(l * 2 + f) * DFF * DM, DM, DFF, DM, 0, (bf16*)(ws + WS_WD) + (size_t)(l * 2 + f) * DM * DFF, 0, scr, gw, NGW, lane);
            transpose_cols(p.cmp_w1 + (size_t)(l * 2 + f) * 4096 * 256, 256, 4096, 256, 0, (bf16*)(ws + WS_W1T) + (size_t)(l * 2 + f) * 256 * 4096, 0, scr, gw, NGW, lane);
            transpose_cols(p.cmp_w2 + (size_t)(l * 2 + f) * 256 * 128, 128, 256, 128, 0, (bf16*)(ws + WS_W2T) + (size_t)(l * 2 + f) * 128 * 256, 0, scr, gw, NGW, lane);
        }
        const float* wi = p.w_in + (size_t)l * DM * INC; bf16* wn = (bf16*)(ws + WS_WNAT) + (size_t)l * NATN * DM; bf16* wv = (bf16*)(ws + WS_WV) + (size_t)l * VTN * DM;
        transpose_cols(wi + 0, INC, DM, 1024, 0, wn, 0, scr, gw, NGW, lane);
        transpose_cols(wi + 1024, INC, DM, 1024, 0, wn, 1024, scr, gw, NGW, lane);
        transpose_cols(wi + 2048, INC, DM, 1024, 0, wv, 0, scr, gw, NGW, lane);
        transpose_cols(wi + 3072, INC, DM, 1024, 0, wn, 2048, scr, gw, NGW, lane);
        transpose_cols(wi + 4096, INC, DM, 256, 0, wn, 3072, scr, gw, NGW, lane);
        transpose_cols(wi + 4352, INC, DM, 256, 0, wn, 3328, scr, gw, NGW, lane);
        transpose_cols(wi + 4608, INC, DM, 256, 0, wn, 3584, scr, gw, NGW, lane);
        transpose_cols(wi + 4864, INC, DM, 256, 0, wv, 1024, scr, gw, NGW, lane);
        transpose_cols(wi + 5120, INC, DM, 256, 0, wn, 3840, scr, gw, NGW, lane);
        transpose_cols(wi + 5376, INC, DM, 256, 0, wv, 1280, scr, gw, NGW, lane);
        transpose_cols(p.w_o + (size_t)l * DM * DM, DM, DM, DM, 0, (bf16*)(ws + WS_WO) + (size_t)l * DM * DM, 0, scr, gw, NGW, lane);
    }
}
__device__ __forceinline__ void norm_phase(const float* x, const float* g, const float* shift, const float* scale, size_t bstride, bf16* h, int gw, int NGW, int lane) {
    for (int m = gw; m < MTOK; m += NGW) {
        const int b = m >> 12;
        const f32x4* xr = (const f32x4*)(x + (size_t)m * DM) + lane;
        f32x4 v[8]; float s = 0.f;
#pragma unroll
        for (int j = 0; j < 8; ++j) { v[j] = xr[64 * j]; s += (v[j].x * v[j].x + v[j].y * v[j].y) + (v[j].z * v[j].z + v[j].w * v[j].w); }
        const float rstd = rsqrtf(wave_sum(s) * (1.f / DM) + RMS_EPS);
        const f32x4* gp = (const f32x4*)g + lane; const f32x4* sh = (const f32x4*)(shift + (size_t)b * bstride) + lane; const f32x4* sc = (const f32x4*)(scale + (size_t)b * bstride) + lane;
        v2u* o = (v2u*)(h + (size_t)m * DM) + lane;
#pragma unroll
        for (int j = 0; j < 8; ++j) { const f32x4 y = (v[j] * rstd) * gp[64 * j] * (sc[64 * j] + 1.0f) + sh[64 * j];
            v2u w; w.x = cvtpk(y.x, y.y); w.y = cvtpk(y.z, y.w); o[64 * j] = w; }
    }
}
__device__ __forceinline__ void final_norm_phase(float* x, const float* g, int gw, int NGW, int lane) {
    for (int m = gw; m < MTOK; m += NGW) {
        f32x4* xr = (f32x4*)(x + (size_t)m * DM) + lane;
        f32x4 v[8]; float s = 0.f;
#pragma unroll
        for (int j = 0; j < 8; ++j) { v[j] = xr[64 * j]; s += (v[j].x * v[j].x + v[j].y * v[j].y) + (v[j].z * v[j].z + v[j].w * v[j].w); }
        const float rstd = rsqrtf(wave_sum(s) * (1.f / DM) + RMS_EPS);
        const f32x4* gp = (const f32x4*)g + lane;
#pragma unroll
        for (int j = 0; j < 8; ++j) xr[64 * j] = (v[j] * rstd) * gp[64 * j];
    }
}
#define MFMA16(a, b, c) __builtin_amdgcn_mfma_f32_16x16x32_bf16((a), (b), (c), 0, 0, 0)
#define MFMA32(a, b, c) __builtin_amdgcn_mfma_f32_32x32x16_bf16((a), (b), (c), 0, 0, 0)
__device__ __forceinline__ bf16x8 ldg8(const bf16* p) { return *(const bf16x8*)p; }
__device__ __forceinline__ void compress_unit(const Params& p, int layer, int u, LAS unsigned char* lds, int tid, int wave, int lane) {
    unsigned char* ws = p.ws;
    const int jj = u >> 6, b = (u >> 5) & 1, g = (u >> 4) & 1, n0 = (u & 15) * 16;
    const bf16* A = (const bf16*)(ws + WS_NAT) + (size_t)((24 + 2 * jj + g) * 2 + b) * (4096 * 128);
    const bf16* W1 = (const bf16*)(ws + WS_W1T) + (size_t)(layer * 2 + jj) * 256 * 4096;
    const bf16* W2 = (const bf16*)(ws + WS_W2T) + (size_t)(layer * 2 + jj) * 128 * 256;
    const float* b1 = (const float*)(ws + WS_BIAS1) + (layer * 2 + jj) * 256;
    const int r16 = lane & 15, kq = lane >> 4;
    int nr = n0 + r16; if (nr > 254) nr = 254;
    const bf16* ap = A + (size_t)nr * 2048 + 8 * kq;
    const bf16* bp0 = W1 + (size_t)(32 * wave + r16) * 4096 + 8 * kq; const bf16* bp1 = bp0 + 16 * 4096;
    f32x4 acc0 = {0.f, 0.f, 0.f, 0.f}, acc1 = {0.f, 0.f, 0.f, 0.f};
#pragma unroll 8
    for (int ks = 0; ks < 128; ++ks) { const bf16x8 a = ldg8(ap + 32 * ks), w0 = ldg8(bp0 + 32 * ks), w1 = ldg8(bp1 + 32 * ks); acc0 = MFMA16(a, w0, acc0); acc1 = MFMA16(a, w1, acc1); }
    LAS bf16* Hs = (LAS bf16*)lds;
#pragma unroll
    for (int i = 0; i < 4; ++i) { const int row = 4 * kq + i, col = 32 * wave + r16;
        Hs[row * 264 + col] = (bf16)f2bf(pg8::silu_f(acc0[i] + b1[col])); Hs[row * 264 + col + 16] = (bf16)f2bf(pg8::silu_f(acc1[i] + b1[col + 16])); }
    __syncthreads();
    f32x4 acc = {0.f, 0.f, 0.f, 0.f};
    const bf16* wp = W2 + (size_t)(16 * wave + r16) * 256 + 8 * kq;
#pragma unroll
    for (int ks = 0; ks < 8; ++ks) { const bf16x8 a = *(const LAS bf16x8*)(Hs + r16 * 264 + 32 * ks + 8 * kq); acc = MFMA16(a, ldg8(wp + 32 * ks), acc); }
    const int dcol = 16 * wave + r16;
#pragma unroll
    for (int i = 0; i < 4; ++i) { const int n = n0 + 4 * kq + i; const bf16 val = (bf16)(n <= 254 ? f2bf(acc[i]) : 0u);
        if (jj == 0) ((bf16*)(ws + WS_KC))[(size_t)(b * 2 + g) * (256 * 128) + ((size_t)((((n >> 5) * 8 + (dcol >> 4)) * 64) + (((dcol >> 3) & 1) * 32 + swap23(n & 31)))) * 8 + (dcol & 7)] = val;
        else ((bf16*)(ws + WS_VCT))[(size_t)(b * 2 + g) * (256 * 128) + ((size_t)(((((dcol >> 5) * 8 + (n >> 5)) * 2 + ((n >> 4) & 1)) * 64) + ((n >> 3) & 1) * 32 + (dcol & 31))) * 8 + (n & 7)] = val; }
    __syncthreads();
}
__device__ __forceinline__ unsigned mask_le(int kbase, int lim) { unsigned r = 0;
#pragma unroll
    for (int i = 0; i < 16; ++i) r |= (unsigned)((kbase + (i & 7) + 16 * (i >> 3)) <= lim) << i;
    return r; }
__device__ __forceinline__ unsigned mask_ge(int kbase, int lim) { unsigned r = 0;
#pragma unroll
    for (int i = 0; i < 16; ++i) r |= (unsigned)((kbase + (i & 7) + 16 * (i >> 3)) >= lim) << i;
    return r; }
template <int NSTEP>
__device__ __forceinline__ f32x16 qk_tile(const bf16* kp, const bf16x8 (&qf)[NSTEP]) {
    f32x16 s;
#pragma unroll
    for (int i = 0; i < 16; ++i) s[i] = 0.f;
#pragma unroll
    for (int st = 0; st < NSTEP; ++st) s = MFMA32(ldg8(kp + st * 512), qf[st], s);
    return s;
}
__device__ __forceinline__ void stat_update(float& m, float& l, const f32x16& s, unsigned allow) {
    float tm = -1e30f;
#pragma unroll
    for (int i = 0; i < 16; ++i) tm = fmaxf(tm, ((allow >> i) & 1u) ? s[i] : -1e30f);
    tm = fmaxf(tm, shx<32>(tm));
    const float mn = fmaxf(m, tm);
    float a = 0.f;
#pragma unroll
    for (int i = 0; i < 16; ++i) a += ((allow >> i) & 1u) ? ex2(s[i] - mn) : 0.f;
    l = l * ex2(m - mn) + a; m = mn;
}
__device__ __forceinline__ bf16x8 pack8(float a0, float a1, float a2, float a3, float a4, float a5, float a6, float a7) {
    v4u w; w.x = cvtpk(a0, a1); w.y = cvtpk(a2, a3); w.z = cvtpk(a4, a5); w.w = cvtpk(a6, a7); return __builtin_bit_cast(bf16x8, w); }
__device__ __forceinline__ void pv_tile(f32x16 (&o)[4], const bf16* vp, int dtstride, const bf16x8 pf0, const bf16x8 pf1) {
#pragma unroll
    for (int dt = 0; dt < 4; ++dt) { o[dt] = MFMA32(ldg8(vp + (size_t)dt * dtstride), pf0, o[dt]); o[dt] = MFMA32(ldg8(vp + (size_t)dt * dtstride + 512), pf1, o[dt]); }
}
__device__ __forceinline__ void imp_accum(const float (&pn)[16], int T, int j, int h, LAS float* row) {
    float ps[16];
#pragma unroll
    for (int i = 0; i < 16; ++i) { float v = pn[i]; v += shx<1>(v); v += shx<2>(v); ps[i] = v; }
    const float eA0 = ps[0] + ps[1] + ps[2] + 0.5f * ps[3], eA1 = 0.5f * ps[3] + ps[4] + ps[5] + ps[6] + 0.5f * ps[7], eA2 = 0.5f * ps[7];
    const float eB0 = ps[8] + ps[9] + ps[10] + 0.5f * ps[11], eB1 = 0.5f * ps[11] + ps[12] + ps[13] + ps[14] + 0.5f * ps[15], eB2 = 0.5f * ps[15];
    const int bA = 8 * T + 2 * h, bB = bA + 4;
    if (j == 0 && h == 0) { row[bA] += eA0; row[bA + 1] += eA1; row[bA + 2] += eA2; row[bB] += eB0; row[bB + 1] += eB1; row[bB + 2] += eB2; }
    LDS_WAIT(); asm volatile("" ::: "memory");
    if (j == 0 && h == 1) { row[bA] += eA0; row[bA + 1] += eA1; row[bA + 2] += eA2; row[bB] += eB0; row[bB + 1] += eB1; row[bB + 2] += eB2; }
    LDS_WAIT(); asm volatile("" ::: "memory");
}
template <bool IMP, class MaskF>
__device__ __forceinline__ void nsa_branch(const bf16* kt, const bf16* vt, int dtstride, int T0, int T1, const bf16x8 (&qf)[8], const MaskF& mf, float gate, f32x16 (&o)[4], LAS float* improw, int j, int h) {
    float m = -1e30f, l = 0.f;
    for (int T = T0; T <= T1; ++T) { const unsigned allow = mf(T); if (!__any(allow != 0u)) continue;
        const f32x16 s = qk_tile<8>(kt + (size_t)T * 4096, qf); stat_update(m, l, s, allow); }
    l += shx<32>(l);
    const float inv = l > 0.f ? 1.0f / l : 0.f;
    for (int T = T0; T <= T1; ++T) { const unsigned allow = mf(T); if (!__any(allow != 0u)) continue;
        const f32x16 s = qk_tile<8>(kt + (size_t)T * 4096, qf);
        float pn[16];
#pragma unroll
        for (int i = 0; i < 16; ++i) pn[i] = ((allow >> i) & 1u) ? ex2(s[i] - m) * inv : 0.f;
        if (IMP) imp_accum(pn, T, j, h, improw);
        const bf16x8 pf0 = pack8(pn[0] * gate, pn[1] * gate, pn[2] * gate, pn[3] * gate, pn[4] * gate, pn[5] * gate, pn[6] * gate, pn[7] * gate);
        const bf16x8 pf1 = pack8(pn[8] * gate, pn[9] * gate, pn[10] * gate, pn[11] * gate, pn[12] * gate, pn[13] * gate, pn[14] * gate, pn[15] * gate);
        pv_tile(o, vt + (size_t)T * 1024, dtstride, pf0, pf1); }
}
__device__ __forceinline__ void nsa_unit(const Params& p, int u, LAS unsigned char* lds, int wave, int lane) {
    unsigned char* ws = p.ws;
    const int bg = u & 3, b = bg >> 1, g = bg & 1, pi = u >> 2;
    const int tb = (wave >> 2) ? 127 - pi : pi, t0w = 32 * tb + 8 * (wave & 3);
    const int c = lane & 31, h = lane >> 5, ti = c >> 2, j = c & 3, t = t0w + ti, head = 4 * g + j;
    const float* gt = (const float*)(ws + WS_GATES) + (size_t)(b * 4096 + t) * 24 + head * 3;
    const float g_c = gt[0], g_s = gt[1], g_w = gt[2];
    const bf16* nat = (const bf16*)(ws + WS_NAT);
    const bf16* qb = nat + (size_t)((16 + head) * 2 + b) * (4096 * 128);
    bf16x8 qf[8];
#pragma unroll
    for (int st = 0; st < 8; ++st) qf[st] = ldg8(qb + ((size_t)(((t >> 5) * 8 + st) * 64 + h * 32 + (t & 31))) * 8);
    f32x16 o[4];
#pragma unroll
    for (int dt = 0; dt < 4; ++dt)
#pragma unroll
        for (int i = 0; i < 16; ++i) o[dt][i] = 0.f;
    LAS float* imp = (LAS float*)(lds + wave * 2304);
    LAS unsigned* selm = (LAS unsigned*)(lds + 8 * 2304 + wave * 64);
    for (int i = lane; i < 8 * 68; i += 64) imp[i] = 0.f;
    LDS_WAIT(); asm volatile("" ::: "memory");
    {
        const int nv = t >= 31 ? ((t - 31) >> 4) + 1 : 0;
        const int nvmax = (t0w + 7) >= 31 ? ((t0w + 7 - 31) >> 4) + 1 : 0;
        const int NT = (nvmax + 31) >> 5;
        const bf16* kt = (const bf16*)(ws + WS_KC) + (size_t)(b * 2 + g) * (256 * 128) + lane * 8;
        const bf16* vt = (const bf16*)(ws + WS_VCT) + (size_t)(b * 2 + g) * (256 * 128) + lane * 8;
        auto mf = [=](int T) -> unsigned { return mask_le(32 * T + 8 * h, nv - 1); };
        nsa_branch<true>(kt, vt, 8 * 1024, 0, NT - 1, qf, mf, g_c, o, imp + ti * 68, j, h);
    }
    {
        const int tk = lane >> 3, sub = lane & 7, cur = t0w >> 6;
        const LAS float* row = imp + tk * 68;
        float sc[8]; int rank[8];
#pragma unroll
        for (int e = 0; e < 8; ++e) { const int mm = sub * 8 + e; const bool valid = mm <= cur, forced = (mm == 0) || (mm == cur) || (mm == cur - 1);
            sc[e] = valid ? (forced ? 3.0e38f : row[mm]) : -1.0f; rank[e] = 0; }
#pragma unroll 4
        for (int mp = 0; mp < 64; ++mp) { const bool validp = mp <= cur, forcedp = (mp == 0) || (mp == cur) || (mp == cur - 1);
            const float sp = validp ? (forcedp ? 3.0e38f : row[mp]) : -1.0f;
#pragma unroll
            for (int e = 0; e < 8; ++e) { const int mm = sub * 8 + e; rank[e] += ((sp > sc[e]) || (sp == sc[e] && mp < mm)) ? 1 : 0; } }
        unsigned byte = 0;
#pragma unroll
        for (int e = 0; e < 8; ++e) byte |= (unsigned)((sc[e] >= 0.f) && (rank[e] < 16)) << e;
        unsigned lo = sub < 4 ? byte << (8 * sub) : 0u, hi = sub >= 4 ? byte << (8 * (sub - 4)) : 0u;
        lo |= shxu<1>(lo); lo |= shxu<2>(lo); lo |= shxu<4>(lo);
        hi |= shxu<1>(hi); hi |= shxu<2>(hi); hi |= shxu<4>(hi);
        if (sub == 0) { selm[tk * 2] = lo; selm[tk * 2 + 1] = hi; }
        LDS_WAIT(); asm volatile("" ::: "memory");
    }
    const unsigned slo = selm[ti * 2], shi = selm[ti * 2 + 1];
    {
        const int cur = t0w >> 6;
        const bf16* kt = nat + (size_t)((28 + g) * 2 + b) * (4096 * 128) + lane * 8;
        const bf16* vt = (const bf16*)(ws + WS_VTT) + ((size_t)((8 + g) * 4) * 256 + b * 128) * 1024 + lane * 8;
        auto mf = [=](int T) -> unsigned { const int blk = T >> 1; const unsigned bit = blk < 32 ? (slo >> blk) & 1u : (shi >> (blk - 32)) & 1u;
            if (!bit) return 0u; return blk == cur ? mask_le(32 * T + 8 * h, t) : 0xFFFFu; };
        nsa_branch<false>(kt, vt, 256 * 1024, 0, 2 * cur + 1, qf, mf, g_s, o, imp, j, h);
    }
    {
        const int T0 = (t0w - 511 > 0 ? t0w - 511 : 0) >> 5, T1 = (t0w + 7) >> 5;
        const bf16* kt = nat + (size_t)((30 + g) * 2 + b) * (4096 * 128) + lane * 8;
        const bf16* vt = (const bf16*)(ws + WS_VTT) + ((size_t)((10 + g) * 4) * 256 + b * 128) * 1024 + lane * 8;
        auto mf = [=](int T) -> unsigned { const int kb = 32 * T + 8 * h; return mask_le(kb, t) & mask_ge(kb, t - 511); };
        nsa_branch<false>(kt, vt, 256 * 1024, T0, T1, qf, mf, g_w, o, imp, j, h);
    }
    bf16* op = (bf16*)(ws + WS_OATT) + (size_t)(b * 4096 + t) * DM + 1024 + head * 128 + 4 * h;
#pragma unroll
    for (int dt = 0; dt < 4; ++dt)
#pragma unroll
        for (int ig = 0; ig < 4; ++ig) { v2u w; w.x = cvtpk(o[dt][4 * ig], o[dt][4 * ig + 1]); w.y = cvtpk(o[dt][4 * ig + 2], o[dt][4 * ig + 3]); *(v2u*)(op + 32 * dt + 8 * ig) = w; }
}
__device__ __forceinline__ void diff_unit(const Params& p, int layer, int u, int wave, int lane) {
    unsigned char* ws = p.ws;
    const int bh = u & 15, b = bh >> 3, head = bh & 7, qi = u >> 4;
    const int qb128 = (wave >> 2) ? 31 - qi : qi, q0 = 128 * qb128 + 32 * (wave & 3);
    const int c = lane & 31, h = lane >> 5, t = q0 + c, Td = q0 >> 5;
    const bf16* nat = (const bf16*)(ws + WS_NAT);
    const bf16* qb = nat + (size_t)(head * 2 + b) * (4096 * 128);
    bf16x8 qf0[4], qf1[4];
#pragma unroll
    for (int st = 0; st < 4; ++st) { qf0[st] = ldg8(qb + ((size_t)(((t >> 5) * 8 + st) * 64 + h * 32 + (t & 31))) * 8); qf1[st] = ldg8(qb + ((size_t)(((t >> 5) * 8 + 4 + st) * 64 + h * 32 + (t & 31))) * 8); }
    const bf16* kt = nat + (size_t)((8 + head) * 2 + b) * (4096 * 128) + lane * 8;
    const bf16* vt = (const bf16*)(ws + WS_VTT) + ((size_t)(head * 4) * 256 + b * 128) * 1024 + lane * 8;
    float m0 = -1e30f, l0 = 0.f, m1 = -1e30f, l1 = 0.f;
    for (int T = 0; T <= Td; ++T) { const unsigned allow = T == Td ? mask_le(32 * T + 8 * h, t) : 0xFFFFu;
        const f32x16 s0 = qk_tile<4>(kt + (size_t)T * 4096, qf0); stat_update(m0, l0, s0, allow);
        const f32x16 s1 = qk_tile<4>(kt + (size_t)T * 4096 + 2048, qf1); stat_update(m1, l1, s1, allow); }
    l0 += shx<32>(l0); l1 += shx<32>(l1);
    const float* lm = (const float*)(ws + WS_LAM) + layer * 2;
    const float il0 = 1.0f / l0, il1 = lm[0] / l1;
    f32x16 o[4];
#pragma unroll
    for (int dt = 0; dt < 4; ++dt)
#pragma unroll
        for (int i = 0; i < 16; ++i) o[dt][i] = 0.f;
    for (int T = 0; T <= Td; ++T) { const unsigned allow = T == Td ? mask_le(32 * T + 8 * h, t) : 0xFFFFu;
        const f32x16 s0 = qk_tile<4>(kt + (size_t)T * 4096, qf0); const f32x16 s1 = qk_tile<4>(kt + (size_t)T * 4096 + 2048, qf1);
        float a[16];
#pragma unroll
        for (int i = 0; i < 16; ++i) a[i] = ((allow >> i) & 1u) ? ex2(s0[i] - m0) * il0 - ex2(s1[i] - m1) * il1 : 0.f;
        pv_tile(o, vt + (size_t)T * 1024, 256 * 1024, pack8(a[0], a[1], a[2], a[3], a[4], a[5], a[6], a[7]), pack8(a[8], a[9], a[10], a[11], a[12], a[13], a[14], a[15])); }
    float ss = 0.f;
#pragma unroll
    for (int dt = 0; dt < 4; ++dt)
#pragma unroll
        for (int i = 0; i < 16; ++i) ss += o[dt][i] * o[dt][i];
    ss += shx<32>(ss);
    const float r = rsqrtf(ss * (1.0f / 128.0f) + RMS_EPS) * lm[1];
    const float* sg = p.diff_subln + layer * 128 + 4 * h;
    bf16* op = (bf16*)(ws + WS_OATT) + (size_t)(b * 4096 + t) * DM + head * 128 + 4 * h;
#pragma unroll
    for (int dt = 0; dt < 4; ++dt)
#pragma unroll
        for (int ig = 0; ig < 4; ++ig) { const f32x4 gv = *(const f32x4*)(sg + 32 * dt + 8 * ig);
            v2u w; w.x = cvtpk(o[dt][4 * ig] * r * gv[0], o[dt][4 * ig + 1] * r * gv[1]); w.y = cvtpk(o[dt][4 * ig + 2] * r * gv[2], o[dt][4 * ig + 3] * r * gv[3]); *(v2u*)(op + 32 * dt + 8 * ig) = w; }
}
constexpr int ATT_STAGE = 32768, ATT_VOFF = 16384;
constexpr int ATT_NSTG = 4, ATT_PD = 3;
constexpr int ATT_EXTRA = 131072 + 1024;
constexpr int ATT_TBL = ATT_EXTRA + 8 * 2176 + 512;
constexpr int ATT_TBL_MAX = 192;
static_assert(ATT_TBL + ATT_TBL_MAX * 16 <= LDS_BYTES, "attention LDS map");
__device__ __forceinline__ void att_bar() { asm volatile("s_waitcnt vmcnt(0) lgkmcnt(0)\n\ts_barrier" ::: "memory"); }
template <int C> __device__ __forceinline__ void att_wait_tile(int after) {
    static_assert(C == 3 || C == 4, "DMA instructions per wave per tile");
    if (after >= 2) { if (C == 3) asm volatile("s_waitcnt vmcnt(6) lgkmcnt(0)\n\ts_barrier" ::: "memory"); else asm volatile("s_waitcnt vmcnt(8) lgkmcnt(0)\n\ts_barrier" ::: "memory"); }
    else if (after == 1) { if (C == 3) asm volatile("s_waitcnt vmcnt(3) lgkmcnt(0)\n\ts_barrier" ::: "memory"); else asm volatile("s_waitcnt vmcnt(4) lgkmcnt(0)\n\ts_barrier" ::: "memory"); }
    else asm volatile("s_waitcnt vmcnt(0) lgkmcnt(0)\n\ts_barrier" ::: "memory");
}
__device__ __forceinline__ void dma_frag(const unsigned char* gsrc_uniform, unsigned lane16, LAS unsigned char* dst) {
    const unsigned long long a_ = (unsigned long long)gsrc_uniform;
    const unsigned d_ = (unsigned)(unsigned long long)dst;
    unsigned keep;
    asm volatile("s_mov_b32 %0, m0\n\ts_mov_b32 m0, %3\n\ts_nop 0\n\tglobal_load_lds_dwordx4 %1, %2\n\ts_mov_b32 m0, %0" : "=&s"(keep) : "v"(lane16), "s"(a_), "s"(d_) : "memory");
}
__device__ __forceinline__ v4u att_desc(const LAS unsigned char* lds, int i) {
    const v4u d = *(const LAS v4u*)(lds + ATT_TBL + i * 16);
    v4u r; r.x = __builtin_amdgcn_readfirstlane(d.x); r.y = __builtin_amdgcn_readfirstlane(d.y); r.z = __builtin_amdgcn_readfirstlane(d.z); r.w = 0u; return r;
}
__device__ __forceinline__ unsigned m32_le(int kb, int lim) { unsigned r = 0;
#pragma unroll
    for (int q = 0; q < 32; ++q) r |= (unsigned)((kb + 32 * (q >> 4) + (q & 7) + 16 * ((q >> 3) & 1)) <= lim) << q;
    return r; }
__device__ __forceinline__ unsigned m32_ge(int kb, int lim) { unsigned r = 0;
#pragma unroll
    for (int q = 0; q < 32; ++q) r |= (unsigned)((kb + 32 * (q >> 4) + (q & 7) + 16 * ((q >> 3) & 1)) >= lim) << q;
    return r; }
template <int NQK>
__device__ __forceinline__ f32x16 qk32(const LAS unsigned char* stg, int sub, const bf16x8 (&qf)[NQK], int lane) {
    const LAS unsigned char* kp = stg + sub * (NQK * 1024) + lane * 16;
    f32x16 s;
#pragma unroll
    for (int i = 0; i < 16; ++i) s[i] = 0.f;
    bf16x8 kf[NQK];
#pragma unroll
    for (int st = 0; st < NQK; ++st) kf[st] = *(const LAS bf16x8*)(kp + st * 1024);
    asm volatile("s_waitcnt lgkmcnt(0)" ::: "memory"); __builtin_amdgcn_sched_barrier(0);
#pragma unroll
    for (int st = 0; st < NQK; ++st) s = MFMA32(kf[st], qf[st], s);
    return s;
}
__device__ __forceinline__ void pv32(f32x16 (&o)[4], const LAS unsigned char* stg, int sub, const bf16x8 pf0, const bf16x8 pf1, int lane) {
    const LAS unsigned char* vp = stg + ATT_VOFF + sub * 2048 + lane * 16;
    bf16x8 vf[8];
#pragma unroll
    for (int dt = 0; dt < 4; ++dt) { vf[2 * dt] = *(const LAS bf16x8*)(vp + dt * 4096); vf[2 * dt + 1] = *(const LAS bf16x8*)(vp + dt * 4096 + 1024); }
    asm volatile("s_waitcnt lgkmcnt(0)" ::: "memory"); __builtin_amdgcn_sched_barrier(0);
#pragma unroll
    for (int dt = 0; dt < 4; ++dt) { o[dt] = MFMA32(vf[2 * dt], pf0, o[dt]); o[dt] = MFMA32(vf[2 * dt + 1], pf1, o[dt]); }
}
__device__ __forceinline__ void online32(float& m, float& l, f32x16 (&o)[4], f32x16& s, unsigned allow, bf16x8& pf0, bf16x8& pf1) {
    const bool full = __all(allow == 0xFFFFu);
    float tm = -1e30f;
    if (full) {
#pragma unroll
        for (int i = 0; i < 16; ++i) tm = fmaxf(tm, s[i]);
    } else {
#pragma unroll
        for (int i = 0; i < 16; ++i) tm = fmaxf(tm, ((allow >> i) & 1u) ? s[i] : -1e30f);
    }
    tm = fmaxf(tm, shx<32>(tm));
    const float mn = fmaxf(m, tm);
    if (!__all(mn == m)) { const float alpha = ex2(m - mn); l *= alpha; m = mn;
#pragma unroll
        for (int dt = 0; dt < 4; ++dt)
#pragma unroll
            for (int i = 0; i < 16; ++i) o[dt][i] *= alpha; }
    float a = 0.f;
    if (full) {
#pragma unroll
        for (int i = 0; i < 16; ++i) { s[i] = ex2(s[i] - m); a += s[i]; }
    } else {
#pragma unroll
        for (int i = 0; i < 16; ++i) { s[i] = ((allow >> i) & 1u) ? ex2(s[i] - m) : 0.f; a += s[i]; }
    }
    l += a;
    pf0 = pack8(s[0], s[1], s[2], s[3], s[4], s[5], s[6], s[7]); pf1 = pack8(s[8], s[9], s[10], s[11], s[12], s[13], s[14], s[15]);
}
#define ATT_PIN() do { asm volatile("s_waitcnt lgkmcnt(0)" ::: "memory"); __builtin_amdgcn_sched_barrier(0); } while (0)
template <int NQK>
__device__ __forceinline__ void tile64_online(const LAS unsigned char* stg, const bf16x8 (&qf)[NQK], unsigned allow, float& m, float& l, f32x16 (&o)[4], int lane) {
    const LAS unsigned char* kp = stg + lane * 16;
    const LAS unsigned char* vp = stg + ATT_VOFF + lane * 16;
    f32x16 s0, s1;
#pragma unroll
    for (int i = 0; i < 16; ++i) { s0[i] = 0.f; s1[i] = 0.f; }
    {   bf16x8 kf[NQK];
#pragma unroll
        for (int st = 0; st < NQK; ++st) kf[st] = *(const LAS bf16x8*)(kp + st * 1024);
        ATT_PIN();
#pragma unroll
        for (int st = 0; st < NQK; ++st) s0 = MFMA32(kf[st], qf[st], s0);
        __builtin_amdgcn_sched_barrier(0);
#pragma unroll
        for (int st = 0; st < NQK; ++st) kf[st] = *(const LAS bf16x8*)(kp + (NQK + st) * 1024);
        ATT_PIN();
#pragma unroll
        for (int st = 0; st < NQK; ++st) s1 = MFMA32(kf[st], qf[st], s1);
        __builtin_amdgcn_sched_barrier(0);
    }
    bf16x8 vf[8];
#pragma unroll
    for (int dt = 0; dt < (NQK == 4 ? 4 : 2); ++dt) { vf[2 * dt] = *(const LAS bf16x8*)(vp + dt * 4096); vf[2 * dt + 1] = *(const LAS bf16x8*)(vp + dt * 4096 + 1024); }
    __builtin_amdgcn_sched_barrier(0);
    const bool full = __all(allow == 0xFFFFFFFFu);
    float tm = -1e30f;
    if (full) {
#pragma unroll
        for (int i = 0; i < 16; ++i) { tm = fmaxf(tm, s0[i]); tm = fmaxf(tm, s1[i]); }
    } else {
#pragma unroll
        for (int i = 0; i < 16; ++i) { tm = fmaxf(tm, ((allow >> i) & 1u) ? s0[i] : -1e30f); tm = fmaxf(tm, ((allow >> (16 + i)) & 1u) ? s1[i] : -1e30f); }
    }
    tm = fmaxf(tm, shx<32>(tm));
    const float mn = fmaxf(m, tm);
    if (!__all(mn == m)) { const float alpha = ex2(m - mn); l *= alpha; m = mn;
#pragma unroll
        for (int dt = 0; dt < 4; ++dt)
#pragma unroll
            for (int i = 0; i < 16; ++i) o[dt][i] *= alpha; }
    float a = 0.f;
    if (full) {
#pragma unroll
        for (int i = 0; i < 16; ++i) { s0[i] = ex2(s0[i] - m); a += s0[i]; }
    } else {
#pragma unroll
        for (int i = 0; i < 16; ++i) { s0[i] = ((allow >> i) & 1u) ? ex2(s0[i] - m) : 0.f; a += s0[i]; }
    }
    { const bf16x8 pf0 = pack8(s0[0], s0[1], s0[2], s0[3], s0[4], s0[5], s0[6], s0[7]), pf1 = pack8(s0[8], s0[9], s0[10], s0[11], s0[12], s0[13], s0[14], s0[15]);
      if (NQK != 4) {
#pragma unroll
          for (int dt = 2; dt < 4; ++dt) { vf[2 * dt] = *(const LAS bf16x8*)(vp + dt * 4096); vf[2 * dt + 1] = *(const LAS bf16x8*)(vp + dt * 4096 + 1024); } }
      ATT_PIN();
#pragma unroll
      for (int dt = 0; dt < 4; ++dt) { o[dt] = MFMA32(vf[2 * dt], pf0, o[dt]); o[dt] = MFMA32(vf[2 * dt + 1], pf1, o[dt]); } }
    __builtin_amdgcn_sched_barrier(0);
#pragma unroll
    for (int dt = 0; dt < 4; ++dt) { vf[2 * dt] = *(const LAS bf16x8*)(vp + 2048 + dt * 4096); vf[2 * dt + 1] = *(const LAS bf16x8*)(vp + 2048 + dt * 4096 + 1024); }
    __builtin_amdgcn_sched_barrier(0);
    if (full) {
#pragma unroll
        for (int i = 0; i < 16; ++i) { s1[i] = ex2(s1[i] - m); a += s1[i]; }
    } else {
#pragma unroll
        for (int i = 0; i < 16; ++i) { s1[i] = ((allow >> (16 + i)) & 1u) ? ex2(s1[i] - m) : 0.f; a += s1[i]; }
    }
    l += a;
    { const bf16x8 pf0 = pack8(s1[0], s1[1], s1[2], s1[3], s1[4], s1[5], s1[6], s1[7]), pf1 = pack8(s1[8], s1[9], s1[10], s1[11], s1[12], s1[13], s1[14], s1[15]);
      ATT_PIN();
#pragma unroll
      for (int dt = 0; dt < 4; ++dt) { o[dt] = MFMA32(vf[2 * dt], pf0, o[dt]); o[dt] = MFMA32(vf[2 * dt + 1], pf1, o[dt]); } }
    __builtin_amdgcn_sched_barrier(0);
}
__device__ __forceinline__ void stash_store(float* scr, const f32x16 (&o)[4], float scale, int lane) {
    float* sp = scr + lane;
#pragma unroll
    for (int dt = 0; dt < 4; ++dt)
#pragma unroll
        for (int i = 0; i < 16; ++i) sp[(dt * 16 + i) * 64] = o[dt][i] * scale;
}
__device__ __forceinline__ void diff_engine(const Params& p, int layer, int u, LAS unsigned char* lds, int bid, int wave, int lane) {
    unsigned char* ws = p.ws;
    const int bh = u & 15, b = bh >> 3, head = bh & 7, qi = u >> 4;
    const int qb128 = (wave >> 2) ? 31 - qi : qi, qw = 128 * qb128 + 32 * (wave & 3);
    const int c = lane & 31, h = lane >> 5, t = qw + c;
    const bf16* qb = (const bf16*)(ws + WS_NAT) + (size_t)(head * 2 + b) * (4096 * 128);
    const size_t kbase_b = WS_NAT + ((size_t)((8 + head) * 2 + b) * (4096 * 128)) * 2;
    const size_t vbase_b = WS_VTT + (((size_t)(head * 4) * 256 + b * 128) * 1024) * 2;
    const unsigned lane16 = (unsigned)lane * 16u;
    float* scr = (float*)(ws + WS_SCR) + (size_t)(bid * NWAVES + wave) * 4096;
    const int NT = 2 * (32 - qi), NS = 2 * NT;
    att_bar();
    for (int i = wave * 64 + lane; i < NS; i += NWAVES * 64) { const int cc = i >= NT ? 1 : 0, T = i - cc * NT;
        v4u d; d.x = (unsigned)(kbase_b + ((size_t)((2 * T) * 8 + 4 * cc) * 512) * 2); d.y = (unsigned)(vbase_b + ((size_t)T * 2048) * 2); d.z = 256u * 1024u * 2u; d.w = 0u;
        *(LAS v4u*)(lds + ATT_TBL + i * 16) = d; }
    att_bar();
    auto issue = [&](int i) {
        const v4u d = att_desc(lds, i);
        LAS unsigned char* stg = lds + (i & (ATT_NSTG - 1)) * ATT_STAGE;
#pragma unroll
        for (int k = 0; k < 3; ++k) { const int f = 3 * wave + k;
            if (f < 8) dma_frag(ws + d.x + ((f >> 2) * 4096 + (f & 3) * 512) * 2, lane16, stg + f * 1024);
            else { const int v = f - 8; dma_frag(ws + d.y + (size_t)(v >> 2) * d.z + (v & 3) * 1024, lane16, stg + ATT_VOFF + v * 1024); } }
    };
    const float* lm = (const float*)(ws + WS_LAM) + layer * 2;
    int step = 0;
    issue(0); issue(1); issue(2);
#pragma unroll 1
    for (int cc = 0; cc < 2; ++cc) {
        bf16x8 qf[4]; f32x16 o[4]; float m = -1e30f, l = 0.f;
        {
            int tq = t, hq = h; asm volatile("" : "+v"(tq), "+v"(hq));
#pragma unroll
            for (int st = 0; st < 4; ++st) qf[st] = ldg8(qb + ((size_t)(((tq >> 5) * 8 + 4 * cc + st) * 64 + hq * 32 + (tq & 31))) * 8);
            asm volatile("s_waitcnt vmcnt(0)" : "+v"(qf[0]), "+v"(qf[1]), "+v"(qf[2]), "+v"(qf[3]));
#pragma unroll
            for (int dt = 0; dt < 4; ++dt)
#pragma unroll
                for (int i = 0; i < 16; ++i) o[dt][i] = 0.f;
        }
#pragma unroll 1
        for (int T = 0; T < NT; ++T, ++step) {
            att_wait_tile<3>(NS - 1 - step);
            if (step + ATT_PD < NS) issue(step + ATT_PD);
            if (64 * T <= qw + 31) {
                const LAS unsigned char* stg = lds + (step & (ATT_NSTG - 1)) * ATT_STAGE;
                const unsigned allow = (64 * T + 63 > qw) ? m32_le(64 * T + 8 * h, t) : 0xFFFFFFFFu;
                tile64_online<4>(stg, qf, allow, m, l, o, lane);
            }
        }
        {
            int ll = lane, tt = t; asm volatile("" : "+v"(ll), "+v"(tt));
            l += shx<32>(l);
            if (cc == 0) stash_store(scr, o, 1.0f / l, ll);
            else {
                const float il1 = lm[0] / l;
                float ss = 0.f;
#pragma unroll
                for (int dt = 0; dt < 4; ++dt)
#pragma unroll
                    for (int i = 0; i < 16; ++i) { const float v = (scr + ll)[(dt * 16 + i) * 64] - o[dt][i] * il1; o[dt][i] = v; ss += v * v; }
                ss += shx<32>(ss);
                const float r = rsqrtf(ss * (1.0f / 128.0f) + RMS_EPS) * lm[1];
                const int hh2 = ll >> 5;
                const float* sg = p.diff_subln + layer * 128 + 4 * hh2;
                bf16* op = (bf16*)(ws + WS_OATT) + (size_t)(b * 4096 + tt) * DM + head * 128 + 4 * hh2;
#pragma unroll
                for (int dt = 0; dt < 4; ++dt)
#pragma unroll
                    for (int ig = 0; ig < 4; ++ig) { const f32x4 gv = *(const f32x4*)(sg + 32 * dt + 8 * ig);
                        v2u w; w.x = cvtpk(o[dt][4 * ig] * r * gv[0], o[dt][4 * ig + 1] * r * gv[1]); w.y = cvtpk(o[dt][4 * ig + 2] * r * gv[2], o[dt][4 * ig + 3] * r * gv[3]); *(v2u*)(op + 32 * dt + 8 * ig) = w; }
            }
        }
    }
    att_bar();
}
__device__ __forceinline__ void nsa_engine(const Params& p, int u, LAS unsigned char* lds, int bid, int wave, int lane) {
    unsigned char* ws = p.ws;
    const int bg = u & 3, b = bg >> 1, g = bg & 1, pi = u >> 2;
    const int tb = (wave >> 2) ? 127 - pi : pi, t0w = 32 * tb + 8 * (wave & 3);
    const int c = lane & 31, h = lane >> 5, ti = c >> 2, j = c & 3, t = t0w + ti, head = 4 * g + j;
    const float* gt = (const float*)(ws + WS_GATES) + (size_t)(b * 4096 + t) * 24 + head * 3;
    float g_c = gt[0], g_s = gt[1], g_w = gt[2];
    asm volatile("s_waitcnt vmcnt(0)" : "+v"(g_c), "+v"(g_s), "+v"(g_w));
    const bf16* qb = (const bf16*)(ws + WS_NAT) + (size_t)((16 + head) * 2 + b) * (4096 * 128);
    bf16x8 qf[8];
#pragma unroll
    for (int st = 0; st < 8; ++st) qf[st] = ldg8(qb + ((size_t)(((t >> 5) * 8 + st) * 64 + h * 32 + (t & 31))) * 8);
    asm volatile("s_waitcnt vmcnt(0)" : "+v"(qf[0]), "+v"(qf[1]), "+v"(qf[2]), "+v"(qf[3]), "+v"(qf[4]), "+v"(qf[5]), "+v"(qf[6]), "+v"(qf[7]));
    float* scr = (float*)(ws + WS_SCR) + (size_t)(bid * NWAVES + wave) * 4096;
    LAS float* imp = (LAS float*)(lds + ATT_EXTRA + wave * 2176);
    LAS unsigned* selm = (LAS unsigned*)(lds + ATT_EXTRA + 8 * 2176 + wave * 64);
    const unsigned lane16 = (unsigned)lane * 16u;
    const int tA = 32 * pi, tB = 32 * (127 - pi);
    const int nvB = (tB >> 4) + 1;
    const int NTc = (nvB + 63) >> 6;
    const int curB = tB >> 6, NSel = curB + 1;
    const int wA0 = (tA - 511 > 0 ? tA - 511 : 0) >> 6, wA1 = (tA + 31) >> 6, wB0 = (tB - 511) >> 6, wB1 = (tB + 31) >> 6;
    const int gap = wB0 > wA1 + 1 ? wB0 - (wA1 + 1) : 0;
    const int NWin = (wB1 - wA0 + 1) - gap;
    const int n1 = 2 * NTc, n2 = n1 + NSel, NS = n2 + NWin;
    auto win_tile = [&](int k) -> int { int w = wA0 + k; if (w > wA1) w += gap; return w; };
    att_bar();
    for (int i = lane; i < 8 * 68; i += 64) imp[i] = 0.f;
    for (int i = wave * 64 + lane; i < NS; i += NWAVES * 64) {
        size_t kb_, vb_; unsigned vdt; int T;
        if (i < n1) { T = i < NTc ? i : i - NTc; kb_ = WS_KC + ((size_t)(b * 2 + g) * (256 * 128)) * 2; vb_ = WS_VCT + ((size_t)(b * 2 + g) * (256 * 128)) * 2; vdt = 8192u * 2u; }
        else { const bool sel = i < n2; T = sel ? i - n1 : win_tile(i - n2);
            kb_ = WS_NAT + ((size_t)(((sel ? 28 : 30) + g) * 2 + b) * (4096 * 128)) * 2; vb_ = WS_VTT + (((size_t)(((sel ? 8 : 10) + g) * 4) * 256 + b * 128) * 1024) * 2; vdt = 256u * 1024u * 2u; }
        v4u d; d.x = (unsigned)(kb_ + ((size_t)T * 8192) * 2); d.y = (unsigned)(vb_ + ((size_t)T * 2048) * 2); d.z = vdt; d.w = 0u;
        *(LAS v4u*)(lds + ATT_TBL + i * 16) = d; }
    att_bar();
    auto issue = [&](int i) {
        const v4u d = att_desc(lds, i);
        LAS unsigned char* stg = lds + (i & (ATT_NSTG - 1)) * ATT_STAGE;
        if (wave < 4) {
#pragma unroll
            for (int k = 0; k < 4; ++k) dma_frag(ws + d.x + (4 * wave + k) * 1024, lane16, stg + (4 * wave + k) * 1024);
        } else { const int dt = wave - 4;
#pragma unroll
            for (int k = 0; k < 4; ++k) dma_frag(ws + d.y + (size_t)dt * d.z + k * 1024, lane16, stg + ATT_VOFF + (dt * 4 + k) * 1024); }
    };
    const int nv = t >= 31 ? ((t - 31) >> 4) + 1 : 0, cur = t0w >> 6;
    f32x16 o[4]; float m = -1e30f, l = 0.f, inv_c = 0.f; unsigned slo = 0u, shi = 0u;
    int step = 0;
    issue(0); issue(1); issue(2);
#pragma unroll 1
    for (int T = 0; T < NTc; ++T, ++step) {
        att_wait_tile<4>(NS - 1 - step);
        if (step + ATT_PD < NS) issue(step + ATT_PD);
        const LAS unsigned char* stg = lds + (step & (ATT_NSTG - 1)) * ATT_STAGE;
        const unsigned allow = m32_le(64 * T + 8 * h, nv - 1);
        if (__any(allow != 0u)) {
#pragma unroll 1
            for (int sub = 0; sub < 2; ++sub) { const unsigned al = (allow >> (16 * sub)) & 0xFFFFu;
                const f32x16 s = qk32<8>(stg, sub, qf, lane);
                float tm = -1e30f;
#pragma unroll
                for (int i = 0; i < 16; ++i) tm = fmaxf(tm, ((al >> i) & 1u) ? s[i] : -1e30f);
                tm = fmaxf(tm, shx<32>(tm));
                const float mn = fmaxf(m, tm); float a = 0.f;
#pragma unroll
                for (int i = 0; i < 16; ++i) a += ((al >> i) & 1u) ? ex2(s[i] - mn) : 0.f;
                l = l * ex2(m - mn) + a; m = mn;
                __builtin_amdgcn_sched_barrier(0); } }
    }
    l += shx<32>(l); inv_c = l > 0.f ? 1.0f / l : 0.f;
#pragma unroll
    for (int dt = 0; dt < 4; ++dt)
#pragma unroll
        for (int i = 0; i < 16; ++i) o[dt][i] = 0.f;
#pragma unroll 1
    for (int T = 0; T < NTc; ++T, ++step) {
        att_wait_tile<4>(NS - 1 - step);
        if (step + ATT_PD < NS) issue(step + ATT_PD);
        const LAS unsigned char* stg = lds + (step & (ATT_NSTG - 1)) * ATT_STAGE;
        const unsigned allow = m32_le(64 * T + 8 * h, nv - 1);
        if (__any(allow != 0u)) {
#pragma unroll 1
            for (int sub = 0; sub < 2; ++sub) { const unsigned al = (allow >> (16 * sub)) & 0xFFFFu;
                const f32x16 s = qk32<8>(stg, sub, qf, lane);
                float pn[16];
#pragma unroll
                for (int i = 0; i < 16; ++i) pn[i] = ((al >> i) & 1u) ? ex2(s[i] - m) * inv_c : 0.f;
                imp_accum(pn, 2 * T + sub, j, h, imp + ti * 68);
                const bf16x8 pf0 = pack8(pn[0] * g_c, pn[1] * g_c, pn[2] * g_c, pn[3] * g_c, pn[4] * g_c, pn[5] * g_c, pn[6] * g_c, pn[7] * g_c);
                const bf16x8 pf1 = pack8(pn[8] * g_c, pn[9] * g_c, pn[10] * g_c, pn[11] * g_c, pn[12] * g_c, pn[13] * g_c, pn[14] * g_c, pn[15] * g_c);
                pv32(o, stg, sub, pf0, pf1, lane);
                __builtin_amdgcn_sched_barrier(0); } }
    }
    {
        int ll = lane; asm volatile("" : "+v"(ll));
        stash_store(scr, o, 1.0f, ll);
        const int tk = ll >> 3, sub = ll & 7;
        const LAS float* row = imp + tk * 68;
        float sc[8]; int rank[8];
#pragma unroll
        for (int e = 0; e < 8; ++e) { const int mm = sub * 8 + e; const bool valid = mm <= cur, forced = (mm == 0) || (mm == cur) || (mm == cur - 1);
            sc[e] = valid ? (forced ? 3.0e38f : row[mm]) : -1.0f; rank[e] = 0; }
#pragma unroll 4
        for (int mp = 0; mp < 64; ++mp) { const bool validp = mp <= cur, forcedp = (mp == 0) || (mp == cur) || (mp == cur - 1);
            const float sp = validp ? (forcedp ? 3.0e38f : row[mp]) : -1.0f;
#pragma unroll
            for (int e = 0; e < 8; ++e) { const int mm = sub * 8 + e; rank[e] += ((sp > sc[e]) || (sp == sc[e] && mp < mm)) ? 1 : 0; } }
        unsigned byte = 0;
#pragma unroll
        for (int e = 0; e < 8; ++e) byte |= (unsigned)((sc[e] >= 0.f) && (rank[e] < 16)) << e;
        unsigned lo = sub < 4 ? byte << (8 * sub) : 0u, hi = sub >= 4 ? byte << (8 * (sub - 4)) : 0u;
        lo |= shxu<1>(lo); lo |= shxu<2>(lo); lo |= shxu<4>(lo);
        hi |= shxu<1>(hi); hi |= shxu<2>(hi); hi |= shxu<4>(hi);
        if (sub == 0) { selm[tk * 2] = lo; selm[tk * 2 + 1] = hi; }
        LDS_WAIT(); asm volatile("" ::: "memory");
        { const int ti2 = (ll & 31) >> 2; slo = selm[ti2 * 2]; shi = selm[ti2 * 2 + 1]; }
    }
    auto reset = [&]() { m = -1e30f; l = 0.f;
#pragma unroll
        for (int dt = 0; dt < 4; ++dt)
#pragma unroll
            for (int i = 0; i < 16; ++i) o[dt][i] = 0.f; };
    auto tile = [&](const LAS unsigned char* stg, unsigned allow) {
        if (__any(allow != 0u)) tile64_online<8>(stg, qf, allow, m, l, o, lane); };
    reset();
#pragma unroll 1
    for (int T = 0; T < NSel; ++T, ++step) {
        att_wait_tile<4>(NS - 1 - step);
        if (step + ATT_PD < NS) issue(step + ATT_PD);
        const unsigned bit = T < 32 ? (slo >> T) & 1u : (shi >> (T - 32)) & 1u;
        const unsigned allow = bit ? (T == cur ? m32_le(64 * T + 8 * h, t) : 0xFFFFFFFFu) : 0u;
        tile(lds + (step & (ATT_NSTG - 1)) * ATT_STAGE, allow);
    }
    {
        int ll = lane; asm volatile("" : "+v"(ll));
        l += shx<32>(l);
        const float sc = g_s / l;
        float* sp = scr + ll;
#pragma unroll
        for (int dt = 0; dt < 4; ++dt)
#pragma unroll
            for (int i = 0; i < 16; ++i) sp[(dt * 16 + i) * 64] += o[dt][i] * sc;
    }
    reset();
#pragma unroll 1
    for (int k = 0; k < NWin; ++k, ++step) {
        att_wait_tile<4>(NS - 1 - step);
        if (step + ATT_PD < NS) issue(step + ATT_PD);
        const int T = win_tile(k);
        const unsigned allow = (64 * T + 63 >= t0w - 511 && 64 * T <= t0w + 7) ? (m32_le(64 * T + 8 * h, t) & m32_ge(64 * T + 8 * h, t - 511)) : 0u;
        tile(lds + (step & (ATT_NSTG - 1)) * ATT_STAGE, allow);
    }
    {
        int ll = lane, tt = t; asm volatile("" : "+v"(ll), "+v"(tt));
        l += shx<32>(l);
        const float sc = g_w / l;
        const float* sp = scr + ll;
        bf16* op = (bf16*)(ws + WS_OATT) + (size_t)(b * 4096 + tt) * DM + 1024 + (4 * g + (ll & 3)) * 128 + 4 * (ll >> 5);
#pragma unroll
        for (int dt = 0; dt < 4; ++dt)
#pragma unroll
            for (int ig = 0; ig < 4; ++ig) { float v[4];
#pragma unroll
                for (int e = 0; e < 4; ++e) v[e] = sp[(dt * 16 + 4 * ig + e) * 64] + o[dt][4 * ig + e] * sc;
                v2u w; w.x = cvtpk(v[0], v[1]); w.y = cvtpk(v[2], v[3]); *(v2u*)(op + 32 * dt + 8 * ig) = w; }
    }
    att_bar();
}
#define LAUNDER_V(x) asm volatile("" : "+v"(x))
#define LAUNDER_S(x) asm volatile("" : "+s"(x))
template <int PH>
__device__ __forceinline__ void run_phase(int it, LAS unsigned char* lds, int wave_s, int rep = 0) {
    const __attribute__((address_space(4))) Params* pp_ = (const __attribute__((address_space(4))) Params*)__builtin_amdgcn_kernarg_segment_ptr(); LAUNDER_S(pp_);
#if defined(__HIP_DEVICE_COMPILE__)
    const Params p = *pp_;
#else
    const Params p{};
#endif
    int wv_ = wave_s; LAUNDER_S(wv_);
    int ln_; asm volatile("v_mbcnt_lo_u32_b32 %0, -1, 0\n\tv_mbcnt_hi_u32_b32 %0, -1, %0" : "=v"(ln_));
    int tid = wv_ * 64 + ln_;
    int bid = blockIdx.x, G = gridDim.x; LAUNDER_S(bid); LAUNDER_S(G);
    unsigned char* ws = p.ws; LAUNDER_S(ws);
    const int lane = tid & 63, wave = __builtin_amdgcn_readfirstlane(tid >> 6), gw = bid * NWAVES + wave, NGW = G * NWAVES;
    const int l = it >> 1, f = it & 1, sub = f ? 2 : 0;
    const float* modl = (const float*)(ws + WS_MOD) + (size_t)l * 2 * NMOD * DM;
    bf16* const H = (bf16*)(ws + WS_H); bf16* const ACT = (bf16*)(ws + WS_ACT); bf16* const OATT = (bf16*)(ws + WS_OATT);
    float* const X = p.out;
    if constexpr (PH == 8) prologue(p, lds, bid, G, tid, wave, lane);
    if constexpr (PH == 9) final_norm_phase(X, p.final_g, gw, NGW, lane);
    if constexpr (PH == 0) norm_phase(X, p.norm_g + (size_t)(l * 3 + sub) * DM, modl + (3 * sub) * DM, modl + (3 * sub + 1) * DM, (size_t)NMOD * DM, H, gw, NGW, lane);
    if constexpr (PH == 3) norm_phase(X, p.norm_g + (size_t)(l * 3 + 1) * DM, modl + 3 * DM, modl + 4 * DM, (size_t)NMOD * DM, H, gw, NGW, lane);
    if constexpr (PH == 1) {
        pg8::Gemm g{H, (const bf16*)(ws + WS_WGU) + (size_t)(l * 2 + f) * NGU * DM, MTOK, NGU, DM}; pg8::StaticOrder S; S.init(MTOK, NGU, G, bid);
        pg8::EpiSwiglu E{ACT, DFF};
        pg8::gemm_phase<pg8::EpiSwiglu, pg8::StaticOrder, PG8_ALIGN, PG8_SP2>(lds + RING_OFF, g, S, E, tid);
    }
    if constexpr (PH == 2) {
        pg8::Gemm g{ACT, (const bf16*)(ws + WS_WD) + (size_t)(l * 2 + f) * DM * DFF, MTOK, DM, DFF}; pg8::StaticOrder S; S.init(MTOK, DM, G, bid);
        pg8::EpiResid E{X, modl + (3 * sub + 2) * DM, NMOD * DM, rep ? 0.0f : 0.5f};
        pg8::gemm_phase<pg8::EpiResid, pg8::StaticOrder, PG8_ALIGN, PG8_SP2>(lds + RING_OFF, g, S, E, tid);
    }
    if constexpr (PH == 4) {
        { pg8::Gemm g{H, (const bf16*)(ws + WS_WNAT) + (size_t)l * NATN * DM, MTOK, NATN, DM}; pg8::StaticOrder S; S.init(MTOK, NATN, G, bid);
          pg8::EpiNat E{(bf16*)(ws + WS_NAT), (float*)(ws + WS_GATES), (const float*)(ws + WS_ROPE), 0.125f * LOG2E, 0.08838834764831845f * LOG2E};
          pg8::gemm_phase<pg8::EpiNat, pg8::StaticOrder, PG8_ALIGN, PG8_SP2>(lds + RING_OFF, g, S, E, tid); }
        { pg8::Gemm g{(const bf16*)(ws + WS_WV) + (size_t)l * VTN * DM, H, VTN, MTOK, DM}; pg8::StaticOrder S; S.init(VTN, MTOK, G, G - 1 - bid);
          pg8::EpiVT E{(bf16*)(ws + WS_VTT)};
          pg8::gemm_phase<pg8::EpiVT, pg8::StaticOrder, PG8_ALIGN, PG8_SP2>(lds + RING_OFF, g, S, E, tid); }
    }
    if constexpr (PH == 5) {
#ifndef REP5
#define REP5 0
#endif
        for (int r5 = 0; r5 < 1 + (REP5 & 1); ++r5)
        for (int u = bid; u < 128; u += G) compress_unit(p, l, u, lds, tid, wave, lane);
#if ATTN_V2
        for (int r5 = 0; r5 < 1 + ((REP5 >> 1) & 1); ++r5)
        for (int u = bid; u < 256; u += G) diff_engine(p, l, u, lds, bid, wave, lane);
#else
        for (int u = bid; u < 256; u += G) diff_unit(p, l, u, wave, lane);
#endif
    }
#if ATTN_V2
    if constexpr (PH == 6) { for (int u = bid; u < 256; u += G) nsa_engine(p, u, lds, bid, wave, lane); }
#else
    if constexpr (PH == 6) { for (int u = bid; u < 256; u += G) nsa_unit(p, u, lds, wave, lane); }
#endif
    if constexpr (PH == 7) {
        pg8::Gemm g{OATT, (const bf16*)(ws + WS_WO) + (size_t)l * DM * DM, MTOK, DM, DM}; pg8::StaticOrder S; S.init(MTOK, DM, G, bid);
        pg8::EpiResid E{X, modl + 5 * DM, NMOD * DM, rep ? 0.0f : 1.0f};
        pg8::gemm_phase<pg8::EpiResid, pg8::StaticOrder, PG8_ALIGN, PG8_SP2>(lds + RING_OFF, g, S, E, tid);
    }
}
template <int PH>
__global__ void __launch_bounds__(NWAVES * 64, 2) phase_kernel(Params p) {
    extern __shared__ __attribute__((aligned(16))) unsigned char lds_raw[];
    run_phase<PH>(p.one_it, (LAS unsigned char*)lds_raw, __builtin_amdgcn_readfirstlane(threadIdx.x >> 6));
}
__global__ void __launch_bounds__(NWAVES * 64, 2) mega_fwd(Params p) {
    extern __shared__ __attribute__((aligned(16))) unsigned char lds_raw[];
    LAS unsigned char* lds = (LAS unsigned char*)lds_raw;
    for (int u = threadIdx.x; u < (LDS_BYTES - LDSCTL_OFF) / 4; u += NWAVES * 64) ((LAS unsigned*)(lds + LDSCTL_OFF))[u] = 0u;
    __syncthreads();
    const int wave_s = __builtin_amdgcn_readfirstlane(threadIdx.x >> 6);
    (void)xcd_barrier_post((unsigned*)(p.ws + WS_CTL) + CW_BAR, (volatile LAS unsigned*)(lds + MISC_OFF) + 8);
#define GRID_BAR() do { const __attribute__((address_space(4))) Params* q_ = (const __attribute__((address_space(4))) Params*)__builtin_amdgcn_kernarg_segment_ptr(); LAUNDER_S(q_); \
        XcdBarrier b_; b_.bar = (unsigned*)(q_->ws + WS_CTL) + CW_BAR; b_.x = xb_xcc_id(); b_.st = (volatile LAS unsigned*)(lds + MISC_OFF) + 8; { int w0_ = wave_s; LAUNDER_S(w0_); unsigned l0_; asm volatile("v_mbcnt_lo_u32_b32 %0, -1, 0\n\tv_mbcnt_hi_u32_b32 %0, -1, %0" : "=v"(l0_)); b_.t0 = (w0_ == 0) && (l0_ == 0u); } xcd_barrier(b_); if (BAR_TWICE) xcd_barrier(b_); } while (0)
#ifndef BAR_TWICE
#define BAR_TWICE 0
#endif
#ifndef EN_MASK
#define EN_MASK 0x3FF
#endif
#ifndef REP_MASK
#define REP_MASK 0
#endif
#define PHREP(n) (((REP_MASK) >> (n)) & 1)
#define PHEN(n) (((EN_MASK) >> (n)) & 1)
    if (PHEN(8)) { for (int r_ = 0; r_ < 1 + PHREP(8); ++r_) { if (r_) GRID_BAR(); run_phase<8>(0, lds, wave_s, r_); } } GRID_BAR();
    for (int it = 0; it < 2 * DEPTH; ++it) {
        if (PHEN(0)) { for (int r_ = 0; r_ < 1 + PHREP(0); ++r_) { if (r_) GRID_BAR(); run_phase<0>(it, lds, wave_s, r_); } } GRID_BAR();
        if (PHEN(1)) { for (int r_ = 0; r_ < 1 + PHREP(1); ++r_) { if (r_) GRID_BAR(); run_phase<1>(it, lds, wave_s, r_); } } GRID_BAR();
        if (PHEN(2)) { for (int r_ = 0; r_ < 1 + PHREP(2); ++r_) { if (r_) GRID_BAR(); run_phase<2>(it, lds, wave_s, r_); } } GRID_BAR();
        if ((it & 1) == 0) {
            if (PHEN(3)) { for (int r_ = 0; r_ < 1 + PHREP(3); ++r_) { if (r_) GRID_BAR(); run_phase<3>(it, lds, wave_s, r_); } } GRID_BAR();
            if (PHEN(4)) { for (int r_ = 0; r_ < 1 + PHREP(4); ++r_) { if (r_) GRID_BAR(); run_phase<4>(it, lds, wave_s, r_); } } GRID_BAR();
            if (PHEN(5)) { for (int r_ = 0; r_ < 1 + PHREP(5); ++r_) { if (r_) GRID_BAR(); run_phase<5>(it, lds, wave_s, r_); } } GRID_BAR();
            if (PHEN(6)) { for (int r_ = 0; r_ < 1 + PHREP(6); ++r_) { if (r_) GRID_BAR(); run_phase<6>(it, lds, wave_s, r_); } } GRID_BAR();
            if (PHEN(7)) { for (int r_ = 0; r_ < 1 + PHREP(7); ++r_) { if (r_) GRID_BAR(); run_phase<7>(it, lds, wave_s, r_); } } GRID_BAR();
        }
    }
    if (PHEN(9)) { for (int r_ = 0; r_ < 1 + PHREP(9); ++r_) { if (r_) GRID_BAR(); run_phase<9>(0, lds, wave_s, r_); } }
#undef GRID_BAR
}

template <int PH> static void launch_phase(Params p, int it, int grid, hipStream_t stream) {
    static bool attr_set = false;
    if (!attr_set) { (void)hipFuncSetAttribute((const void*)phase_kernel<PH>, hipFuncAttributeMaxDynamicSharedMemorySize, LDS_BYTES); attr_set = true; }
    p.one_it = it; p.one_ph = PH;
    hipLaunchKernelGGL(phase_kernel<PH>, dim3(grid), dim3(NWAVES * 64), LDS_BYTES, stream, p);
}
extern "C" void kernel_launch(void* const* d_in, const int* in_sizes, int n_in, void* d_out, int out_size, void* d_ws, size_t ws_size, hipStream_t stream) {
    static int grid = 0;
    if (grid == 0) {
        if (n_in != 15 || in_sizes[0] != MTOK * DM || out_size != MTOK * DM || ws_size < WS_END) {
            fprintf(stderr, "kernel_launch: unexpected shapes (n_in %d, in0 %d, out %d, ws %zu, need %zu); nothing launched\n", n_in, n_in > 0 ? in_sizes[0] : -1, out_size, ws_size, (size_t)WS_END); grid = -1; return; }
        int dev = 0, cus = 0, per_cu = 0;
        if (hipGetDevice(&dev) != hipSuccess || hipDeviceGetAttribute(&cus, hipDeviceAttributeMultiprocessorCount, dev) != hipSuccess) { fprintf(stderr, "kernel_launch: device query failed\n"); grid = -1; return; }
        if (hipFuncSetAttribute((const void*)mega_fwd, hipFuncAttributeMaxDynamicSharedMemorySize, LDS_BYTES) != hipSuccess) { fprintf(stderr, "kernel_launch: hipFuncSetAttribute failed\n"); grid = -1; return; }
        if (hipOccupancyMaxActiveBlocksPerMultiprocessor(&per_cu, (const void*)mega_fwd, NWAVES * 64, LDS_BYTES) != hipSuccess || per_cu < 1)
            fprintf(stderr, "kernel_launch: note: occupancy query reports %d workgroups per CU\n", per_cu);
        (void)hipGetLastError();
        grid = cus;
    }
    if (grid < 0) return;
    if (hipMemsetAsync((char*)d_ws + WS_CTL, 0, CTL_ZERO_BYTES, stream) != hipSuccess) { fprintf(stderr, "kernel_launch: memset failed\n"); return; }
    Params p{};
    p.x = (const float*)d_in[0]; p.c = (const float*)d_in[1]; p.w_ada = (const float*)d_in[2]; p.b_ada = (const float*)d_in[3]; p.norm_g = (const float*)d_in[4];
    p.w_gu = (const float*)d_in[5]; p.w_d = (const float*)d_in[6]; p.w_in = (const float*)d_in[7]; p.w_o = (const float*)d_in[8]; p.diff_lam = (const float*)d_in[9];
    p.diff_subln = (const float*)d_in[10]; p.cmp_pe = (const float*)d_in[11]; p.cmp_w1 = (const float*)d_in[12]; p.cmp_w2 = (const float*)d_in[13]; p.final_g = (const float*)d_in[14];
    p.out = (float*)d_out; p.ws = (unsigned char*)d_ws;
#if MK_MULTI
    launch_phase<8>(p, 0, grid, stream);
#ifdef REPEAT_PRO
    launch_phase<8>(p, 0, grid, stream);
#endif
    for (int it = 0; it < 2 * DEPTH; ++it) {
        launch_phase<0>(p, it, grid, stream); launch_phase<1>(p, it, grid, stream); launch_phase<2>(p, it, grid, stream);
        if ((it & 1) == 0) { launch_phase<3>(p, it, grid, stream); launch_phase<4>(p, it, grid, stream); launch_phase<5>(p, it, grid, stream); launch_phase<6>(p, it, grid, stream);
#ifdef REPEAT_ATTN
            launch_phase<5>(p, it, grid, stream); launch_phase<6>(p, it, grid, stream);
#endif
 launch_phase<7>(p, it, grid, stream); }
    }
    launch_phase<9>(p, 0, grid, stream);
#else
    p.one_it = -1; p.one_ph = 0;
    hipLaunchKernelGGL(mega_fwd, dim3(grid), dim3(NWAVES * 64), LDS_BYTES, stream, p);
#endif
    const hipError_t le = hipPeekAtLastError();
    if (le != hipSuccess) fprintf(stderr, "kernel_launch: launch failed: %s\n", hipGetErrorName(le));
}
```

```cpp
#include <hip/hip_runtime.h>
#include <hip/hip_bf16.h>
#include <cstdio>
#include <cstdint>
namespace pg8 {
#define PG8_LAS __attribute__((address_space(3)))
typedef unsigned short bf16_t;
typedef short bf16x8 __attribute__((ext_vector_type(8)));
typedef float f32x4 __attribute__((ext_vector_type(4)));
typedef unsigned u32x4 __attribute__((ext_vector_type(4)));
constexpr int BM = 256, BK = 64, HALF = 128, HTB = HALF * BK * 2  , STAGE_BYTES = 8 * HTB, NXCD = 8, WGM = 8;

__host__ __device__ __forceinline__ int lds_byte(int r, int c) { const int st = (r >> 4) * 2 + (c >> 5), rr = r & 15, cc = c & 31, ob = rr * 64 + cc * 2; return st * 1024 + (ob ^ (((ob >> 9) & 1) << 5)); }
__host__ __device__ __forceinline__ void stage_rc(int b, int& R, int& C) { const int st = b / 1024, sb = b % 1024, swz = sb ^ (((sb >> 9) & 1) << 5); R = (st >> 1) * 16 + swz / 64; C = (st & 1) * 32 + (swz % 64) / 2; }
__host__ __device__ __forceinline__ int perm32(int rho) { const int n = rho >> 4, i = rho & 15; return 8 * (i >> 2) + 4 * n + (i & 3); }

struct Unit { int pm, pn; };
struct Gemm { const bf16_t* A; const bf16_t* Bt; int M, N, K; };

struct StaticOrder {
    int nM, nN, nwg, G, c;
    __host__ __device__ void init(int M, int N, int G_, int c_) { nM = M / BM; nN = N / BM; nwg = nM * nN; G = G_; c = c_; }
    __host__ __device__ bool next(int i, Unit& u) const {
        const long L = (long)i * G + c; if (L >= nwg) return false;
        int wgid = (int)L; { const int q = nwg / NXCD, r = nwg % NXCD, xcd = wgid % NXCD, off = wgid / NXCD; wgid = (xcd < r ? xcd * (q + 1) : r * (q + 1) + (xcd - r) * q) + off; }
        const int nig = WGM * nN, gid = wgid / nig, fm = gid * WGM, gsz = (nM - fm) < WGM ? (nM - fm) : WGM;
        u.pm = fm + ((wgid % nig) % gsz); u.pn = (wgid % nig) / gsz; return true;
    }
    __device__ __forceinline__ void a_ready(const Unit&) const {}
    __device__ __forceinline__ void done(const Unit&) const {}
};

__device__ __forceinline__ unsigned cvt_pk_bf16(float lo, float hi) { unsigned r; asm volatile("v_cvt_pk_bf16_f32 %0, %1, %2" : "=v"(r) : "v"(lo), "v"(hi)); return r; }
typedef float f32x2 __attribute__((ext_vector_type(2)));
typedef float f32x2_t __attribute__((ext_vector_type(2))); typedef __bf16 bf16x2_t __attribute__((ext_vector_type(2)));
__device__ __forceinline__ unsigned cvtpk(float lo, float hi) { f32x2_t v = {lo, hi}; bf16x2_t b = __builtin_convertvector(v, bf16x2_t); return __builtin_bit_cast(unsigned, b); }
__host__ __device__ __forceinline__ int swap23(int r) { return (r & ~12) | ((r & 4) << 1) | ((r & 8) >> 1); }
__device__ __forceinline__ float silu_f(float g) { return g * __builtin_amdgcn_rcpf(1.0f + __builtin_amdgcn_exp2f(-1.4426950408889634f * g)); }
__device__ __forceinline__ float sigmoid_f(float g) { return __builtin_amdgcn_rcpf(1.0f + __builtin_amdgcn_exp2f(-1.4426950408889634f * g)); }

template <int K> __device__ __forceinline__ float shx(float v) {
    if constexpr (K < 32) return __builtin_bit_cast(float, __builtin_amdgcn_ds_swizzle(__builtin_bit_cast(int, v), (K << 10) | 0x1f));
    else { const unsigned u = __builtin_bit_cast(unsigned, v); auto rr = __builtin_amdgcn_permlane32_swap(u, u, false, false);
        unsigned lo; asm volatile("v_mbcnt_lo_u32_b32 %0, -1, 0" : "=v"(lo));
        return __builtin_bit_cast(float, lo >= 32u ? rr[0] : rr[1]); }
}
template <int K> __device__ __forceinline__ unsigned shxu(unsigned v) { return __builtin_bit_cast(unsigned, shx<K>(__builtin_bit_cast(float, v))); }
struct EpiSwiglu {
    static constexpr bool PERM = true, AFTER_DRAIN = false;
    bf16_t* act; int ldc;
    __device__ __forceinline__ void operator()(const f32x4 (&acc)[2][2][4][2], const Unit& u, int wr, int wc, int fr, int fq) const {
        const int row0 = u.pm * BM + wr * 64 + fr, col0 = u.pn * 128 + wc * 32 + 8 * fq;
#pragma unroll
        for (int ai = 0; ai < 2; ++ai)
#pragma unroll
            for (int m = 0; m < 4; ++m) {
                bf16_t* rowp = act + (size_t)(row0 + ai * HALF + m * 16) * ldc + col0;
                const f32x4 g0 = acc[ai][0][m][0], g1 = acc[ai][0][m][1], u0 = acc[ai][1][m][0], u1 = acc[ai][1][m][1];
                u32x4 w;
                w.x = cvtpk(silu_f(g0[0]) * u0[0], silu_f(g0[1]) * u0[1]); w.y = cvtpk(silu_f(g0[2]) * u0[2], silu_f(g0[3]) * u0[3]);
                w.z = cvtpk(silu_f(g1[0]) * u1[0], silu_f(g1[1]) * u1[1]); w.w = cvtpk(silu_f(g1[2]) * u1[2], silu_f(g1[3]) * u1[3]);
                *(u32x4*)rowp = w;
            }
    }
};
struct EpiResid {
    static constexpr bool PERM = false, AFTER_DRAIN = false;
    float* x; const float* gate; int gstride; float coef;
    __device__ __forceinline__ void operator()(const f32x4 (&acc)[2][2][4][2], const Unit& u, int wr, int wc, int fr, int fq) const {
        const int row0 = u.pm * BM + wr * 64 + fr, col0 = u.pn * BM + wc * 32 + 4 * fq;
        const float* gp = gate + (size_t)(u.pm >> 4) * gstride;
#pragma unroll
        for (int bj = 0; bj < 2; ++bj)
#pragma unroll
            for (int n = 0; n < 2; ++n) {
                const int col = col0 + bj * HALF + n * 16;
                const f32x4 gv = *(const f32x4*)(gp + col) * coef;
#pragma unroll
                for (int ai = 0; ai < 2; ++ai)
#pragma unroll
                    for (int m = 0; m < 4; ++m) {
                        float* p = x + (size_t)(row0 + ai * HALF + m * 16) * 2048 + col;
                        const f32x4 xv = *(const f32x4*)p;
                        *(f32x4*)p = xv + gv * acc[ai][bj][m][n];
                    }
            }
    }
};
struct EpiVT {
    static constexpr bool PERM = true, AFTER_DRAIN = false;
    bf16_t* vtt;
    __device__ __forceinline__ void operator()(const f32x4 (&acc)[2][2][4][2], const Unit& u, int wr, int wc, int fr, int fq) const {
#pragma unroll
        for (int ai = 0; ai < 2; ++ai)
#pragma unroll
            for (int m = 0; m < 4; ++m) {
                const int row = u.pm * BM + ai * HALF + wr * 64 + m * 16 + fr, slot = row >> 7, dt = (row >> 5) & 3, d = row & 31;
#pragma unroll
                for (int bj = 0; bj < 2; ++bj) {
                    const int tc = 32 * u.pn + 16 * bj + 4 * wc + fq, T = tc >> 2, s = (tc >> 1) & 1, h2 = tc & 1;
                    const f32x4 v0 = acc[ai][bj][m][0], v1 = acc[ai][bj][m][1];
                    u32x4 w; w.x = cvtpk(v0[0], v0[1]); w.y = cvtpk(v0[2], v0[3]); w.z = cvtpk(v1[0], v1[1]); w.w = cvtpk(v1[2], v1[3]);
                    *(u32x4*)(vtt + ((size_t)((((slot * 4 + dt) * 256 + T) * 2 + s) * 64 + h2 * 32 + d)) * 8) = w;
                }
            }
    }
};
struct EpiNat {
    static constexpr bool PERM = true, AFTER_DRAIN = false;
    bf16_t* nat; float* gates; const float* rope; float qs_d, qs_n; bf16_t* kvc;
    __device__ __forceinline__ void operator()(const f32x4 (&acc)[2][2][4][2], const Unit& u, int wr, int wc, int fr, int fq) const {
        asm volatile("" : "+v"(fr), "+v"(fq));
#pragma unroll
        for (int bj = 0; bj < 2; ++bj) {
            const int slot = 2 * u.pn + bj;
            if (slot >= 33) continue;
            const bool r64 = slot < 16, r128 = (slot >= 16 && slot < 24) || (slot >= 28 && slot < 32);
            const bool ktype = (slot >= 8 && slot < 16) || (slot >= 28 && slot < 32);
            const float sc = slot < 8 ? qs_d : ((slot >= 16 && slot < 24) ? qs_n : 1.0f);
#pragma unroll
            for (int ai = 0; ai < 2; ++ai)
#pragma unroll
                for (int m = 0; m < 4; ++m) {
                    const int row = u.pm * BM + ai * HALF + wr * 64 + m * 16 + fr, b = row >> 12, t = row & 4095;
                    float v[8];
#pragma unroll
                    for (int e = 0; e < 4; ++e) { v[e] = acc[ai][bj][m][0][e]; v[4 + e] = acc[ai][bj][m][1][e]; }
                    if (slot == 32) {
                        if (wc == 0 && fq < 3) {
                            float* gp = gates + (size_t)row * 24 + 8 * fq;
                            *(f32x4*)gp = (f32x4){sigmoid_f(v[0]), sigmoid_f(v[1]), sigmoid_f(v[2]), sigmoid_f(v[3])};
                            *(f32x4*)(gp + 4) = (f32x4){sigmoid_f(v[4]), sigmoid_f(v[5]), sigmoid_f(v[6]), sigmoid_f(v[7])};
                        }
                        continue;
                    }
                    const float* rp = rope + (size_t)t * 48;
                    if (r64 && (wc & 1) == 0) {
                        const f32x4 c0 = *(const f32x4*)(rp), c1 = *(const f32x4*)(rp + 4), s0 = *(const f32x4*)(rp + 8), s1 = *(const f32x4*)(rp + 12);
#pragma unroll
                        for (int e = 0; e < 8; ++e) {
                            const float pv = shx<16>(v[e]), cs = e < 4 ? c0[e & 3] : c1[e & 3], sn = e < 4 ? s0[e & 3] : s1[e & 3];
                            const float rot = fq == 0 ? v[e] * cs - pv * sn : v[e] * cs + pv * sn;
                            v[e] = fq < 2 ? rot : v[e];
                        }
                    }
                    if (r128 && wc == 0) {
                        const float* cp = rp + 16 + 8 * (fq & 1); const float* sp = rp + 32 + 8 * (fq & 1);
                        const f32x4 c0 = *(const f32x4*)(cp), c1 = *(const f32x4*)(cp + 4), s0 = *(const f32x4*)(sp), s1 = *(const f32x4*)(sp + 4);
#pragma unroll
                        for (int e = 0; e < 8; ++e) {
                            const float pv = shx<32>(v[e]), cs = e < 4 ? c0[e & 3] : c1[e & 3], sn = e < 4 ? s0[e & 3] : s1[e & 3];
                            v[e] = fq < 2 ? v[e] * cs - pv * sn : v[e] * cs + pv * sn;
                        }
                    }
                    u32x4 w; w.x = cvtpk(v[0] * sc, v[1] * sc); w.y = cvtpk(v[2] * sc, v[3] * sc); w.z = cvtpk(v[4] * sc, v[5] * sc); w.w = cvtpk(v[6] * sc, v[7] * sc);
                    const int dc = 4 * wc + fq;
                    bf16_t* base = nat + (size_t)(slot * 2 + b) * (4096 * 128);
                    if (slot >= 24 && slot < 28) *(u32x4*)(kvc + ((size_t)((slot - 24) * 2 + b) * 4096 + t) * 136 + dc * 8) = w;
                    else { const int rp2 = ktype ? swap23(t & 31) : (t & 31);
                        *(u32x4*)(base + ((size_t)(((t >> 5) * 8 + (dc >> 1)) * 64 + (dc & 1) * 32 + rp2)) * 8) = w; }
                }
        }
    }
};
template <class Epi, class Sched, bool ALIGN_EPI = false, bool SP2 = false>
__device__ __forceinline__ void gemm_phase(PG8_LAS unsigned char* lds, const Gemm g, const Sched& S, const Epi& E, int tid0_) {
    asm volatile("" : "+v"(tid0_));
    const int tid = tid0_, wid = __builtin_amdgcn_readfirstlane(tid >> 6), lane = tid & 63, wr = wid >> 2, wc = wid & 3, fr = lane & 15, fq = lane >> 4;
    const int K = g.K, nt = K / BK;
    unsigned voffA[2], voffB[2];
#pragma unroll
    for (int i = 0; i < 2; ++i) { int R, C; stage_rc(tid * 16 + i * 8192, R, C); const int Rb = Epi::PERM ? ((R & ~31) + perm32(R & 31)) : R;
        voffA[i] = (unsigned)(R * K + C) * 2u; voffB[i] = (unsigned)(Rb * K + C) * 2u; }
    const size_t kstep = (size_t)(BK * 2);
    const size_t hstep = (size_t)HALF * K * 2;
    const size_t tstep = 2 * hstep;
    const unsigned ldsw = (unsigned)wid * 1024u;
    const int aoff = lds_byte(wr * 64 + fr, fq * 8), boff = lds_byte(wc * 32 + fr, fq * 8);
#define PG8_SA(b, h) (((b) * 2 + (h)) * HTB)
#define PG8_SB(b, h) ((4 + (b) * 2 + (h)) * HTB)
#define PG8_STAGE(bufoff, gbase, voff) do { _Pragma("unroll") for (int _i = 0; _i < 2; ++_i) \
        __builtin_amdgcn_global_load_lds((const unsigned*)((const char*)(gbase) + (voff)[_i]), (PG8_LAS unsigned*)(lds + (bufoff) + ldsw + _i * 8192), 16, 0, 0); } while (0)
#define PG8_LDA(dst, b, h) do { _Pragma("unroll") for (int m = 0; m < 4; ++m) _Pragma("unroll") for (int k = 0; k < 2; ++k) dst[m][k] = *(const PG8_LAS bf16x8*)(lds + PG8_SA(b, h) + aoff + m * 2048 + k * 1024); } while (0)
#define PG8_LDB(dst, b, h) do { _Pragma("unroll") for (int n = 0; n < 2; ++n) _Pragma("unroll") for (int k = 0; k < 2; ++k) dst[n][k] = *(const PG8_LAS bf16x8*)(lds + PG8_SB(b, h) + boff + n * 2048 + k * 1024); } while (0)
#define PG8_MMA(ai, bj, At, Bt) do { __builtin_amdgcn_s_setprio(1); _Pragma("unroll") for (int m = 0; m < 4; ++m) _Pragma("unroll") for (int n = 0; n < 2; ++n) _Pragma("unroll") for (int k = 0; k < 2; ++k) \
        acc[ai][bj][m][n] = __builtin_amdgcn_mfma_f32_16x16x32_bf16(Bt[n][k], At[m][k], acc[ai][bj][m][n], 0, 0, 0); __builtin_amdgcn_s_setprio(0); } while (0)
#define PG8_WAIT_V(n) asm volatile("s_waitcnt vmcnt(" #n ")" ::: "memory")
#define PG8_WAIT_L(n) asm volatile("s_waitcnt lgkmcnt(" #n ")" ::: "memory")
#define PG8_BAR __builtin_amdgcn_s_barrier()
#define PG8_SCHED __builtin_amdgcn_sched_barrier(0)
    Unit cur, nxt; int ui = 0;
    if (!S.next(0, cur)) return;
    f32x4 acc[2][2][4][2];
#pragma unroll
    for (int a = 0; a < 2; ++a)
#pragma unroll
        for (int b = 0; b < 2; ++b)
#pragma unroll
            for (int m = 0; m < 4; ++m)
#pragma unroll
                for (int n = 0; n < 2; ++n) acc[a][b][m][n] = (f32x4){0.f, 0.f, 0.f, 0.f};
    bf16x8 At[4][2], B0[2][2], B1[2][2];
    const char* cA = (const char*)g.A + (size_t)cur.pm * tstep; const char* cB = (const char*)g.Bt + (size_t)cur.pn * tstep;
    S.a_ready(cur);
    if constexpr (SP2) {
        PG8_STAGE(PG8_SB(0, 0), cB, voffB); PG8_STAGE(PG8_SB(0, 1), cB + hstep, voffB); PG8_STAGE(PG8_SA(0, 0), cA, voffA); PG8_STAGE(PG8_SA(0, 1), cA + hstep, voffA);
        if (wr == 1) PG8_BAR;
        PG8_WAIT_V(2); PG8_BAR;
        PG8_STAGE(PG8_SB(1, 0), cB + kstep, voffB); PG8_STAGE(PG8_SA(1, 0), cA + kstep, voffA); PG8_STAGE(PG8_SB(1, 1), cB + hstep + kstep, voffB);
        PG8_WAIT_V(6); PG8_BAR;
    } else {
        PG8_STAGE(PG8_SB(0, 0), cB, voffB); PG8_STAGE(PG8_SA(0, 0), cA, voffA); PG8_STAGE(PG8_SB(0, 1), cB + hstep, voffB); PG8_STAGE(PG8_SA(0, 1), cA + hstep, voffA);
        if (wr == 1) PG8_BAR;
        PG8_WAIT_V(4); PG8_BAR;
        PG8_STAGE(PG8_SB(1, 0), cB + kstep, voffB); PG8_STAGE(PG8_SA(1, 0), cA + kstep, voffA); PG8_STAGE(PG8_SB(1, 1), cB + hstep + kstep, voffB);
        PG8_WAIT_V(6); PG8_BAR;
    }
    for (;;) {
        const bool has_next = S.next(ui + 1, nxt);
        const char* nA = has_next ? (const char*)g.A + (size_t)nxt.pm * tstep : cA; const char* nB = has_next ? (const char*)g.Bt + (size_t)nxt.pn * tstep : cB;
        for (int t = 0; t < nt; t += 2) {
            const bool last = (t == nt - 2);
            const char* a1 = cA + (size_t)(t + 1) * kstep;
            const char* a2 = last ? nA : cA + (size_t)(t + 2) * kstep; const char* b2 = last ? nB : cB + (size_t)(t + 2) * kstep;
            const char* a3 = a2 + kstep; const char* b3 = b2 + kstep;
            if (last && has_next) S.a_ready(nxt);
            if constexpr (SP2) {
            PG8_LDB(B0, 0, 0); PG8_LDB(B1, 0, 1); PG8_SCHED; PG8_LDA(At, 0, 0); PG8_STAGE(PG8_SA(1, 1), a1 + hstep, voffA);
            PG8_WAIT_V(8); PG8_WAIT_L(0); PG8_BAR; PG8_MMA(0, 0, At, B0); PG8_MMA(0, 1, At, B1); PG8_BAR; PG8_SCHED;
            PG8_LDA(At, 0, 1); PG8_STAGE(PG8_SB(0, 0), b2, voffB); PG8_STAGE(PG8_SB(0, 1), b2 + hstep, voffB); PG8_STAGE(PG8_SA(0, 0), a2, voffA);
            PG8_WAIT_V(8); PG8_WAIT_L(0); PG8_BAR; PG8_MMA(1, 0, At, B0); PG8_MMA(1, 1, At, B1); PG8_BAR; PG8_SCHED;
            PG8_LDB(B0, 1, 0); PG8_LDB(B1, 1, 1); PG8_SCHED; PG8_LDA(At, 1, 0); PG8_STAGE(PG8_SA(0, 1), a2 + hstep, voffA);
            PG8_WAIT_V(8); PG8_WAIT_L(0); PG8_BAR; PG8_MMA(0, 0, At, B0); PG8_MMA(0, 1, At, B1); PG8_BAR; PG8_SCHED;
            PG8_LDA(At, 1, 1); PG8_STAGE(PG8_SB(1, 0), b3, voffB); PG8_STAGE(PG8_SB(1, 1), b3 + hstep, voffB); PG8_STAGE(PG8_SA(1, 0), a3, voffA);
            PG8_WAIT_V(8); PG8_WAIT_L(0); PG8_BAR; PG8_MMA(1, 0, At, B0); PG8_MMA(1, 1, At, B1); PG8_BAR; PG8_SCHED;
            } else {
            PG8_LDB(B0, 0, 0); PG8_SCHED; PG8_LDA(At, 0, 0); PG8_STAGE(PG8_SA(1, 1), a1 + hstep, voffA);
            PG8_WAIT_L(8); PG8_BAR; PG8_WAIT_L(0); PG8_MMA(0, 0, At, B0); PG8_BAR; PG8_SCHED;
            PG8_LDB(B1, 0, 1); PG8_STAGE(PG8_SB(0, 0), b2, voffB);
            PG8_BAR; PG8_WAIT_L(0); PG8_MMA(0, 1, At, B1); PG8_BAR;
            PG8_LDA(At, 0, 1); PG8_STAGE(PG8_SA(0, 0), a2, voffA);
            PG8_BAR; PG8_WAIT_L(0); PG8_MMA(1, 0, At, B0); PG8_BAR; PG8_SCHED;
            PG8_STAGE(PG8_SB(0, 1), b2 + hstep, voffB);
            PG8_WAIT_V(6); PG8_BAR; PG8_MMA(1, 1, At, B1); PG8_BAR;
            PG8_LDB(B0, 1, 0); PG8_SCHED; PG8_LDA(At, 1, 0); PG8_STAGE(PG8_SA(0, 1), a2 + hstep, voffA);
            PG8_WAIT_L(8); PG8_BAR; PG8_WAIT_L(0); PG8_MMA(0, 0, At, B0); PG8_BAR; PG8_SCHED;
            PG8_LDB(B1, 1, 1); PG8_STAGE(PG8_SB(1, 0), b3, voffB);
            PG8_BAR; PG8_WAIT_L(0); PG8_MMA(0, 1, At, B1); PG8_BAR;
            PG8_LDA(At, 1, 1); PG8_STAGE(PG8_SA(1, 0), a3, voffA);
            PG8_BAR; PG8_WAIT_L(0); PG8_MMA(1, 0, At, B0); PG8_BAR; PG8_SCHED;
            PG8_STAGE(PG8_SB(1, 1), b3 + hstep, voffB);
            PG8_WAIT_V(6); PG8_BAR; PG8_MMA(1, 1, At, B1); PG8_BAR;
            }
        }
        if constexpr (ALIGN_EPI) { if (wr == 0) PG8_BAR; }
        if constexpr (!Epi::AFTER_DRAIN) { E(acc, cur, wr, wc, fr, fq); S.done(cur); }
        if (!has_next) break;
#pragma unroll
        for (int a = 0; a < 2; ++a)
#pragma unroll
            for (int b = 0; b < 2; ++b)
#pragma unroll
                for (int m = 0; m < 4; ++m)
#pragma unroll
                    for (int n = 0; n < 2; ++n) acc[a][b][m][n] = (f32x4){0.f, 0.f, 0.f, 0.f};
        cur = nxt; cA = nA; cB = nB; ++ui;
        if constexpr (ALIGN_EPI) { if (wr == 1) PG8_BAR; }
    }
    PG8_WAIT_V(0);
    if constexpr (!ALIGN_EPI) { if (wr == 0) PG8_BAR; }
    PG8_BAR;
    if constexpr (Epi::AFTER_DRAIN) { E.fused(acc, cur, wr, wc, fr, fq, lds, wid, lane); S.done(cur); }
#undef PG8_SA
#undef PG8_SB
#undef PG8_STAGE
#undef PG8_LDA
#undef PG8_LDB
#undef PG8_MMA
#undef PG8_WAIT_V
#undef PG8_WAIT_L
#undef PG8_BAR
#undef PG8_SCHED
}
}
#ifndef PG8_SP2
#define PG8_SP2 true
#endif
#ifndef PG8_ALIGN
#define PG8_ALIGN true
#endif
constexpr int NWAVES = 8;
constexpr int BATCH = 2, SEQ = 4096, DM = 2048, MTOK = BATCH * SEQ, DEPTH = 4, DFF = 5632, NGU = 2 * DFF, INC = 5656;
constexpr int NATN = 4352, VTN = 1536, NMOD = 9;
constexpr float RMS_EPS = 1e-6f;
constexpr float LOG2E = 1.4426950408889634f;
#ifndef ATTN_V2
#define ATTN_V2 1
#endif
#ifndef MK_MULTI
#define MK_MULTI 0
#endif
constexpr size_t al256(size_t x) { return (x + 255) & ~(size_t)255; }
constexpr size_t WS_CTL = 0, CTL_ZERO_BYTES = 1u << 20;
constexpr size_t WS_MOD = CTL_ZERO_BYTES;
constexpr size_t WS_ROPE = al256(WS_MOD + (size_t)DEPTH * BATCH * NMOD * DM * 4);
constexpr size_t WS_BIAS1 = al256(WS_ROPE + (size_t)SEQ * 48 * 4);
constexpr size_t WS_LAM = al256(WS_BIAS1 + (size_t)DEPTH * 2 * 256 * 4);
constexpr size_t WS_WGU = al256(WS_LAM + 256);
constexpr size_t WS_WD = al256(WS_WGU + (size_t)DEPTH * 2 * NGU * DM * 2);
constexpr size_t WS_WNAT = al256(WS_WD + (size_t)DEPTH * 2 * DM * DFF * 2);
constexpr size_t WS_WV = al256(WS_WNAT + (size_t)DEPTH * NATN * DM * 2);
constexpr size_t WS_WO = al256(WS_WV + (size_t)DEPTH * VTN * DM * 2);
constexpr size_t WS_W1T = al256(WS_WO + (size_t)DEPTH * DM * DM * 2);
constexpr size_t WS_W2T = al256(WS_W1T + (size_t)DEPTH * 2 * 256 * 4096 * 2);
constexpr size_t WS_H = al256(WS_W2T + (size_t)DEPTH * 2 * 128 * 256 * 2);
constexpr size_t WS_ACT = al256(WS_H + (size_t)MTOK * DM * 2);
constexpr size_t WS_NAT = al256(WS_ACT + (size_t)MTOK * DFF * 2);
constexpr size_t WS_VTT = al256(WS_NAT + (size_t)32 * MTOK * 128 * 2);
constexpr size_t WS_KC = al256(WS_VTT + (size_t)VTN * MTOK * 2);
constexpr size_t WS_VCT = al256(WS_KC + (size_t)4 * 256 * 128 * 2);
constexpr size_t WS_GATES = al256(WS_VCT + (size_t)4 * 256 * 128 * 2);
constexpr size_t WS_OATT = al256(WS_GATES + (size_t)MTOK * 24 * 4);
constexpr size_t WS_SCR = al256(WS_OATT + (size_t)MTOK * DM * 2);
constexpr size_t WS_KVC = al256(WS_SCR + (size_t)512 * 8 * 4096 * 4);
constexpr size_t WS_END = al256(WS_KVC + (size_t)8 * 4096 * 136 * 2);
constexpr int CW_BAR = 4096;
constexpr int RING_OFF = 0, RING_BYTES = 131072;
constexpr int LDSCTL_OFF = RING_BYTES, MISC_OFF = LDSCTL_OFF + 320;
constexpr int LDS_BYTES = 155648;

#define GAS __attribute__((address_space(1)))
#define LAS __attribute__((address_space(3)))
typedef unsigned short bf16;
typedef unsigned v4u __attribute__((ext_vector_type(4)));
typedef unsigned v2u __attribute__((ext_vector_type(2)));
typedef float f32x4 __attribute__((ext_vector_type(4)));
typedef float f32x16 __attribute__((ext_vector_type(16)));
typedef short bf16x8 __attribute__((ext_vector_type(8)));
typedef GAS unsigned gu32;
#define RLX_AGENT __ATOMIC_RELAXED, __HIP_MEMORY_SCOPE_AGENT
#define LDS_WAIT() asm volatile("s_waitcnt lgkmcnt(0)" ::: "memory")
using pg8::cvtpk; using pg8::swap23; using pg8::shx; using pg8::shxu;
__device__ __forceinline__ unsigned f2bf(float f) { unsigned u = __builtin_bit_cast(unsigned, f); return (u + 0x7fffu + ((u >> 16) & 1u)) >> 16; }
__device__ __forceinline__ unsigned pk2(float lo, float hi) { return f2bf(lo) | (f2bf(hi) << 16); }
__device__ __forceinline__ float ex2(float x) { return __builtin_amdgcn_exp2f(x); }
#define XB_TMO      128
#define XB_XCNT(j)  (256  + 64 * (j))
#define XB_XSUB(j)  (1280 + 64 * (j))
#define XB_XGEN(j)  (2304 + 64 * (j))
#define XB_TOP      3328
#define XB_TOPGEN   3392
#define XCD_BAR_WORDS 3456
#define XB_SPIN_CAP (1u << 18)

__device__ __forceinline__ unsigned xb_ld(unsigned* p)              { return __hip_atomic_load(p, __ATOMIC_RELAXED, __HIP_MEMORY_SCOPE_AGENT); }
__device__ __forceinline__ unsigned xb_add(unsigned* p, unsigned v) { return __hip_atomic_fetch_add(p, v, __ATOMIC_RELAXED, __HIP_MEMORY_SCOPE_AGENT); }
__device__ __forceinline__ unsigned xb_xcc_id() { return (unsigned)__builtin_amdgcn_s_getreg((3 << 11) | 20) & 0xFu; }
#define XB_SPIN(cond, bar) do { unsigned _sp = 0; while (cond) { __builtin_amdgcn_s_sleep(1); \
    if ((++_sp & 255u) == 0u) { if (xb_ld(&(bar)[XB_TMO])) break; if (_sp > XB_SPIN_CAP) { atomicAdd(&(bar)[XB_TMO], 1u); break; } } } } while (0)

struct XcdBarrier {
    unsigned* bar; unsigned x; bool t0;
    volatile LAS unsigned* st;
};

__device__ __forceinline__ XcdBarrier xcd_barrier_post(unsigned* bar, volatile LAS unsigned* st) {
    XcdBarrier b; b.bar = bar; b.x = xb_xcc_id(); b.st = st; b.t0 = (threadIdx.x == 0);
    if (threadIdx.x == 0) (void)xb_add(&bar[XB_XCNT(b.x)], 1u);
    return b;
}
__device__ __forceinline__ void xcd_barrier_complete(unsigned* bar, unsigned x, unsigned& nloc, unsigned& nx) {
    const unsigned G = gridDim.x * gridDim.y * gridDim.z;
    unsigned sum, cnt, mine, sp = 0u;
    for (;;) {
        sum = 0u; cnt = 0u; mine = 0u;
#pragma unroll
        for (unsigned j = 0; j < 16; ++j) { const unsigned c = xb_ld(&bar[XB_XCNT(j)]); sum += c; cnt += (c > 0u) ? 1u : 0u; mine = (j == x) ? c : mine; }
        if (sum == G) break;
        __builtin_amdgcn_s_sleep(1);
        if ((++sp & 255u) == 0u) { if (xb_ld(&bar[XB_TMO])) break; if (sp > XB_SPIN_CAP) { atomicAdd(&bar[XB_TMO], 1u); break; } }
    }
    nloc = mine > 0u ? mine : 1u; nx = cnt > 0u ? cnt : 1u;
}

__device__ __forceinline__ void xcd_barrier(const XcdBarrier& b) {
    asm volatile("s_waitcnt vmcnt(0)" ::: "memory");
    __syncthreads();
    if (b.t0) {
        unsigned* bar = b.bar;
        __builtin_amdgcn_s_waitcnt(0);
        unsigned nloc = b.st[0], nx = b.st[1];
        if (nloc == 0u) { xcd_barrier_complete(bar, b.x, nloc, nx); b.st[0] = nloc; b.st[1] = nx; }
        const unsigned old = xb_add(&bar[XB_XSUB(b.x)], 1u);
        const unsigned gen = old / nloc;
        if (old + 1u == (gen + 1u) * nloc) {
            __builtin_amdgcn_fence(__ATOMIC_RELEASE, "agent");
            asm volatile("s_waitcnt vmcnt(0)" ::: "memory");
            const unsigned og = xb_add(&bar[XB_TOP], 1u);
            const unsigned tg = og / nx;
            if (og + 1u == (tg + 1u) * nx) xb_add(&bar[XB_TOPGEN], 1u);
            else XB_SPIN(xb_ld(&bar[XB_TOPGEN]) == tg, bar);
            __builtin_amdgcn_fence(__ATOMIC_ACQUIRE, "agent");
            xb_add(&bar[XB_XGEN(b.x)], 1u);
            asm volatile("s_waitcnt vmcnt(0)" ::: "memory");
        } else {
            XB_SPIN(xb_ld(&bar[XB_XGEN(b.x)]) == gen, bar);
            __builtin_amdgcn_fence(__ATOMIC_ACQUIRE, "agent");
            asm volatile("s_waitcnt vmcnt(0)" ::: "memory");
        }
    }
    __syncthreads();
}
struct Params {
    const float *x, *c, *w_ada, *b_ada, *norm_g, *w_gu, *w_d, *w_in, *w_o, *diff_lam, *diff_subln, *cmp_pe, *cmp_w1, *cmp_w2, *final_g;
    float* out; unsigned char* ws; int one_it, one_ph;
};
__device__ __forceinline__ float wave_sum(float v) {
    v += shx<1>(v); v += shx<2>(v); v += shx<4>(v); v += shx<8>(v); v += shx<16>(v); v += shx<32>(v);
    return v;
}
template <bool FRAG = false>
__device__ __forceinline__ void transpose_item(const float* W, size_t ldw, int K, int k0, int n0, bf16* WT, int dst_row, LAS float* scr, int lane) {
#pragma unroll 8
    for (int i = 0; i < 32; ++i) { const int kk = 2 * i + (lane >> 5); scr[kk * 33 + (lane & 31)] = W[(size_t)(k0 + kk) * ldw + n0 + (lane & 31)]; }
    LDS_WAIT(); asm volatile("" ::: "memory");
    const int c = lane & 7;
#pragma unroll
    for (int j = 0; j < 4; ++j) { const int n = (lane >> 3) + 8 * j; const LAS float* s = scr + (8 * c) * 33 + n;
        v4u o; o.x = pk2(s[0 * 33], s[1 * 33]); o.y = pk2(s[2 * 33], s[3 * 33]); o.z = pk2(s[4 * 33], s[5 * 33]); o.w = pk2(s[6 * 33], s[7 * 33]);
        if (FRAG) { const int ng = dst_row + n, k8 = (k0 >> 3) + c; *(v4u*)(WT + ((size_t)(((ng >> 4) * (K >> 5) + (k8 >> 2)) * 64) + (k8 & 3) * 16 + (ng & 15)) * 8) = o; }
        else *(v4u*)(WT + (size_t)(dst_row + n) * K + k0 + 8 * c) = o; }
    LDS_WAIT(); asm volatile("" ::: "memory");
}
__device__ __forceinline__ void transpose_cols(const float* W, size_t ldw, int K, int ncols, int map, bf16* WT, int dst0, LAS float* scr, int gw, int NGW, int lane) {
    const int nblk = ncols / 32, nitems = (K / 64) * nblk;
    for (int it = gw; it < nitems; it += NGW) {
        const int kb = it / nblk, nb = it % nblk, n0 = nb * 32;
        int dr = dst0 + n0;
        if (map == 1) { const int n = n0 < DFF ? n0 : n0 - DFF; dr = 256 * (n >> 7) + (n & 127) + (n0 < DFF ? 0 : 128); }
        if (map == 2) transpose_item<true>(W, ldw, K, kb * 64, n0, WT, dr, scr, lane); else transpose_item<false>(W, ldw, K, kb * 64, n0, WT, dr, scr, lane);
    }
}
template <int NB, bool SILU>
__device__ __forceinline__ void gemv_unit(const float* W, size_t ldw, int K, const float* vec, size_t vstride, float* out, size_t ostride, const float* bias, LAS unsigned char* lds, int tid, int wave, int lane) {
    LAS float* vs = (LAS float*)lds;
    LAS float* part = (LAS float*)(lds + 32768);
    for (int i = tid; i < NB * K; i += NWAVES * 64) { const int b = i / K, k = i % K; float v = vec[(size_t)b * vstride + k]; if (SILU) v = v / (1.0f + __expf(-v)); vs[i] = v; }
    __syncthreads();
    f32x4 acc[NB];
#pragma unroll
    for (int b = 0; b < NB; ++b) acc[b] = (f32x4){0.f, 0.f, 0.f, 0.f};
    const int kc = K / NWAVES, kbeg = wave * kc;
    const float* wp = W + (size_t)kbeg * ldw + 4 * lane;
#pragma unroll 8
    for (int k = 0; k < kc; ++k) { const f32x4 wv = *(const f32x4*)(wp + (size_t)k * ldw);
#pragma unroll
        for (int b = 0; b < NB; ++b) acc[b] += vs[b * K + kbeg + k] * wv; }
#pragma unroll
    for (int b = 0; b < NB; ++b) *(LAS f32x4*)(part + (wave * NB + b) * 256 + 4 * lane) = acc[b];
    __syncthreads();
    if (tid < NB * 256) { const int b = tid >> 8, n = tid & 255; float s = bias ? bias[n] : 0.f;
#pragma unroll
        for (int w = 0; w < NWAVES; ++w) s += part[(w * NB + b) * 256 + n];
        out[(size_t)b * ostride + n] = s; }
    __syncthreads();
}
__device__ __forceinline__ void prologue(const Params& p, LAS unsigned char* lds, int bid, int G, int tid, int wave, int lane) {
    unsigned char* ws = p.ws;
    const int gw = bid * NWAVES + wave, NGW = G * NWAVES;
    for (int u = bid; u < 288 + 8; u += G) {
        if (u < 288) { const int l = u / 72, n0 = (u % 72) * 256;
            gemv_unit<2, true>(p.w_ada + (size_t)l * DM * (NMOD * DM) + n0, (size_t)NMOD * DM, DM, p.c, DM, (float*)(ws + WS_MOD) + (size_t)l * 2 * NMOD * DM + n0, (size_t)NMOD * DM, p.b_ada + (size_t)l * NMOD * DM + n0, lds, tid, wave, lane);
        } else { const int lj = u - 288;
            gemv_unit<1, false>(p.cmp_w1 + (size_t)lj * 4096 * 256, 256, 4096, p.cmp_pe + (size_t)lj * 4096, 0, (float*)(ws + WS_BIAS1) + lj * 256, 0, nullptr, lds, tid, wave, lane);
        }
    }
    { const f32x4* s = (const f32x4*)p.x; f32x4* d = (f32x4*)p.out; const size_t n4 = (size_t)MTOK * DM / 4;
      for (size_t i = (size_t)bid * (NWAVES * 64) + tid; i < n4; i += (size_t)G * (NWAVES * 64)) d[i] = s[i]; }
    { float* rp = (float*)(ws + WS_ROPE);
      for (int i = bid * (NWAVES * 64) + tid; i < SEQ * 24; i += G * (NWAVES * 64)) { const int t = i / 24, k = i % 24;
          const int half = k < 8 ? 8 : 16, ii = k < 8 ? k : k - 8;
          const float inv = expf((-13.122363377404328f * (float)ii) / (float)half), ang = (float)t * inv;
          const float cs = cosf(ang), sn = sinf(ang);
          if (k < 8) { rp[t * 48 + ii] = cs; rp[t * 48 + 8 + ii] = sn; } else { rp[t * 48 + 16 + ii] = cs; rp[t * 48 + 32 + ii] = sn; } } }
    if (bid == 0 && tid < DEPTH) { const float* lf = p.diff_lam + tid * 4 * 64; float s01 = 0.f, s23 = 0.f;
        for (int i = 0; i < 64; ++i) { s01 += lf[i] * lf[64 + i]; s23 += lf[128 + i] * lf[192 + i]; }
        const float li = 0.8f - 0.6f * expf(-0.3f * (float)tid);
        float* o = (float*)(ws + WS_LAM) + tid * 2; o[0] = expf(s01) - expf(s23) + li; o[1] = 1.0f - li; }
    for (int i = bid * (NWAVES * 64) + tid; i < DEPTH * 24 * DM; i += G * (NWAVES * 64)) { const int l = i / (24 * DM), r = i % (24 * DM), cidx = r / DM, k = r % DM;
        ((bf16*)(ws + WS_WNAT))[((size_t)l * NATN + 4096 + cidx) * DM + k] = (bf16)f2bf(p.w_in[((size_t)l * DM + k) * INC + 5632 + cidx]); }
    LAS float* scr = (LAS float*)(lds + wave * 16384);
    for (int l = 0; l < DEPTH; ++l) {
        for (int f = 0; f < 2; ++f) {
            transpose_cols(p.w_gu + (size_t)(l * 2 + f) * DM * NGU, NGU, DM, NGU, 1, (bf16*)(ws + WS_WGU) + (size_t)(l * 2 + f) * NGU * DM, 0, scr, gw, NGW, lane);
            transpose_cols(p.w_d + (size_t)(l * 2 + f) * DFF * DM, DM, DFF, DM, 0, (bf16*)(ws + WS_WD) + (size_t)(l * 2 + f) * DM * DFF, 0, scr, gw, NGW, lane);
            transpose_cols(p.cmp_w1 + (size_t)(l * 2 + f) * 4096 * 256, 256, 4096, 256, 2, (bf16*)(ws + WS_W1T) + (size_t)(l * 2 + f) * 256 * 4096, 0, scr, gw, NGW, lane);
            transpose_cols(p.cmp_w2 + (size_t)(l * 2 + f) * 256 * 128, 128, 256, 128, 0, (bf16*)(ws + WS_W2T) + (size_t)(l * 2 + f) * 128 * 256, 0, scr, gw, NGW, lane);
        }
        const float* wi = p.w_in + (size_t)l * DM * INC; bf16* wn = (bf16*)(ws + WS_WNAT) + (size_t)l * NATN * DM; bf16* wv = (bf16*)(ws + WS_WV) + (size_t)l * VTN * DM;
        transpose_cols(wi + 0, INC, DM, 1024, 0, wn, 0, scr, gw, NGW, lane);
        transpose_cols(wi + 1024, INC, DM, 1024, 0, wn, 1024, scr, gw, NGW, lane);
        transpose_cols(wi + 2048, INC, DM, 1024, 0, wv, 0, scr, gw, NGW, lane);
        transpose_cols(wi + 3072, INC, DM, 1024, 0, wn, 2048, scr, gw, NGW, lane);
        transpose_cols(wi + 4096, INC, DM, 256, 0, wn, 3072, scr, gw, NGW, lane);
        transpose_cols(wi + 4352, INC, DM, 256, 0, wn, 3328, scr, gw, NGW, lane);
        transpose_cols(wi + 4608, INC, DM, 256, 0, wn, 3584, scr, gw, NGW, lane);
        transpose_cols(wi + 4864, INC, DM, 256, 0, wv, 1024, scr, gw, NGW, lane);
        transpose_cols(wi + 5120, INC, DM, 256, 0, wn, 3840, scr, gw, NGW, lane);
        transpose_cols(wi + 5376, INC, DM, 256, 0, wv, 1280, scr, gw, NGW, lane);
        transpose_cols(p.w_o + (size_t)l * DM * DM, DM, DM, DM, 0, (bf16*)(ws + WS_WO) + (size_t)l * DM * DM, 0, scr, gw, NGW, lane);
    }
}
__device__ __forceinline__ void norm_phase(const float* x, const float* g, const float* shift, const float* scale, size_t bstride, bf16* h, int gw, int NGW, int lane) {
    for (int m = gw; m < MTOK; m += NGW) {
        const int b = m >> 12;
        const f32x4* xr = (const f32x4*)(x + (size_t)m * DM) + lane;
        f32x4 v[8]; float s = 0.f;
#pragma unroll
        for (int j = 0; j < 8; ++j) { v[j] = xr[64 * j]; s += (v[j].x * v[j].x + v[j].y * v[j].y) + (v[j].z * v[j].z + v[j].w * v[j].w); }
        const float rstd = rsqrtf(wave_sum(s) * (1.f / DM) + RMS_EPS);
        const f32x4* gp = (const f32x4*)g + lane; const f32x4* sh = (const f32x4*)(shift + (size_t)b * bstride) + lane; const f32x4* sc = (const f32x4*)(scale + (size_t)b * bstride) + lane;
        v2u* o = (v2u*)(h + (size_t)m * DM) + lane;
#pragma unroll
        for (int j = 0; j < 8; ++j) { const f32x4 y = (v[j] * rstd) * gp[64 * j] * (sc[64 * j] + 1.0f) + sh[64 * j];
            v2u w; w.x = cvtpk(y.x, y.y); w.y = cvtpk(y.z, y.w); o[64 * j] = w; }
    }
}
__device__ __forceinline__ void final_norm_phase(float* x, const float* g, int gw, int NGW, int lane) {
    for (int m = gw; m < MTOK; m += NGW) {
        f32x4* xr = (f32x4*)(x + (size_t)m * DM) + lane;
        f32x4 v[8]; float s = 0.f;
#pragma unroll
        for (int j = 0; j < 8; ++j) { v[j] = xr[64 * j]; s += (v[j].x * v[j].x + v[j].y * v[j].y) + (v[j].z * v[j].z + v[j].w * v[j].w); }
        const float rstd = rsqrtf(wave_sum(s) * (1.f / DM) + RMS_EPS);
        const f32x4* gp = (const f32x4*)g + lane;
#pragma unroll
        for (int j = 0; j < 8; ++j) xr[64 * j] = (v[j] * rstd) * gp[64 * j];
    }
}
#define MFMA16(a, b, c) __builtin_amdgcn_mfma_f32_16x16x32_bf16((a), (b), (c), 0, 0, 0)
#define MFMA32(a, b, c) __builtin_amdgcn_mfma_f32_32x32x16_bf16((a), (b), (c), 0, 0, 0)
__device__ __forceinline__ bf16x8 ldg8(const bf16* p) { return *(const bf16x8*)p; }
__device__ __forceinline__ void compress_unit(const Params& p, int layer, int u, LAS unsigned char* lds, int tid, int wave, int lane) {
    unsigned char* ws = p.ws;
    const int jj = u >> 6, b = (u >> 5) & 1, g = (u >> 4) & 1, n0 = (u & 15) * 16;
    const bf16* A = (const bf16*)(ws + WS_KVC) + (size_t)((2 * jj + g) * 2 + b) * (4096 * 136);
    const bf16* W1 = (const bf16*)(ws + WS_W1T) + (size_t)(layer * 2 + jj) * 256 * 4096;
    const bf16* W2 = (const bf16*)(ws + WS_W2T) + (size_t)(layer * 2 + jj) * 128 * 256;
    const float* b1 = (const float*)(ws + WS_BIAS1) + (layer * 2 + jj) * 256;
    const int r16 = lane & 15, kq = lane >> 4;
    int nr = n0 + r16; if (nr > 254) nr = 254;
    const bf16* ap = A + (size_t)(16 * nr) * 136 + 8 * kq;
    const bf16* bp0 = W1 + ((size_t)(2 * wave) * 128 * 64 + lane) * 8; const bf16* bp1 = bp0 + (size_t)128 * 64 * 8;
    f32x4 acc0 = {0.f, 0.f, 0.f, 0.f}, acc1 = {0.f, 0.f, 0.f, 0.f};
#pragma unroll 1
    for (int kb = 0; kb < 16; ++kb) {
        bf16x8 av[8], w0[8], w1[8];
#pragma unroll
        for (int i = 0; i < 8; ++i) { av[i] = ldg8(ap + (size_t)(2 * kb + (i >> 2)) * 136 + 32 * (i & 3)); w0[i] = ldg8(bp0 + (size_t)(8 * kb + i) * 512); w1[i] = ldg8(bp1 + (size_t)(8 * kb + i) * 512); }
        asm volatile("s_waitcnt vmcnt(0)" ::: "memory"); __builtin_amdgcn_sched_barrier(0);
#pragma unroll
        for (int i = 0; i < 8; ++i) { acc0 = MFMA16(av[i], w0[i], acc0); acc1 = MFMA16(av[i], w1[i], acc1); }
        __builtin_amdgcn_sched_barrier(0);
    }
    LAS bf16* Hs = (LAS bf16*)lds;
#pragma unroll
    for (int i = 0; i < 4; ++i) { const int row = 4 * kq + i, col = 32 * wave + r16;
        Hs[row * 264 + col] = (bf16)f2bf(pg8::silu_f(acc0[i] + b1[col])); Hs[row * 264 + col + 16] = (bf16)f2bf(pg8::silu_f(acc1[i] + b1[col + 16])); }
    __syncthreads();
    f32x4 acc = {0.f, 0.f, 0.f, 0.f};
    const bf16* wp = W2 + (size_t)(16 * wave + r16) * 256 + 8 * kq;
#pragma unroll
    for (int ks = 0; ks < 8; ++ks) { const bf16x8 a = *(const LAS bf16x8*)(Hs + r16 * 264 + 32 * ks + 8 * kq); acc = MFMA16(a, ldg8(wp + 32 * ks), acc); }
    const int dcol = 16 * wave + r16;
#pragma unroll
    for (int i = 0; i < 4; ++i) { const int n = n0 + 4 * kq + i; const bf16 val = (bf16)(n <= 254 ? f2bf(acc[i]) : 0u);
        if (jj == 0) ((bf16*)(ws + WS_KC))[(size_t)(b * 2 + g) * (256 * 128) + ((size_t)((((n >> 5) * 8 + (dcol >> 4)) * 64) + (((dcol >> 3) & 1) * 32 + swap23(n & 31)))) * 8 + (dcol & 7)] = val;
        else ((bf16*)(ws + WS_VCT))[(size_t)(b * 2 + g) * (256 * 128) + ((size_t)(((((dcol >> 5) * 8 + (n >> 5)) * 2 + ((n >> 4) & 1)) * 64) + ((n >> 3) & 1) * 32 + (dcol & 31))) * 8 + (n & 7)] = val; }
    __syncthreads();
}
__device__ __forceinline__ unsigned mask_le(int kbase, int lim) { unsigned r = 0;
#pragma unroll
    for (int i = 0; i < 16; ++i) r |= (unsigned)((kbase + (i & 7) + 16 * (i >> 3)) <= lim) << i;
    return r; }
__device__ __forceinline__ unsigned mask_ge(int kbase, int lim) { unsigned r = 0;
#pragma unroll
    for (int i = 0; i < 16; ++i) r |= (unsigned)((kbase + (i & 7) + 16 * (i >> 3)) >= lim) << i;
    return r; }
template <int NSTEP>
__device__ __forceinline__ f32x16 qk_tile(const bf16* kp, const bf16x8 (&qf)[NSTEP]) {
    f32x16 s;
#pragma unroll
    for (int i = 0; i < 16; ++i) s[i] = 0.f;
#pragma unroll
    for (int st = 0; st < NSTEP; ++st) s = MFMA32(ldg8(kp + st * 512), qf[st], s);
    return s;
}
__device__ __forceinline__ void stat_update(float& m, float& l, const f32x16& s, unsigned allow) {
    float tm = -1e30f;
#pragma unroll
    for (int i = 0; i < 16; ++i) tm = fmaxf(tm, ((allow >> i) & 1u) ? s[i] : -1e30f);
    tm = fmaxf(tm, shx<32>(tm));
    const float mn = fmaxf(m, tm);
    float a = 0.f;
#pragma unroll
    for (int i = 0; i < 16; ++i) a += ((allow >> i) & 1u) ? ex2(s[i] - mn) : 0.f;
    l = l * ex2(m - mn) + a; m = mn;
}
__device__ __forceinline__ bf16x8 pack8(float a0, float a1, float a2, float a3, float a4, float a5, float a6, float a7) {
    v4u w; w.x = cvtpk(a0, a1); w.y = cvtpk(a2, a3); w.z = cvtpk(a4, a5); w.w = cvtpk(a6, a7); return __builtin_bit_cast(bf16x8, w); }
__device__ __forceinline__ void pv_tile(f32x16 (&o)[4], const bf16* vp, int dtstride, const bf16x8 pf0, const bf16x8 pf1) {
#pragma unroll
    for (int dt = 0; dt < 4; ++dt) { o[dt] = MFMA32(ldg8(vp + (size_t)dt * dtstride), pf0, o[dt]); o[dt] = MFMA32(ldg8(vp + (size_t)dt * dtstride + 512), pf1, o[dt]); }
}
__device__ __forceinline__ void imp_accum(const float (&pn)[16], int T, int j, int h, LAS float* row) {
    float ps[16];
#pragma unroll
    for (int i = 0; i < 16; ++i) { float v = pn[i]; v += shx<1>(v); v += shx<2>(v); ps[i] = v; }
    const float eA0 = ps[0] + ps[1] + ps[2] + 0.5f * ps[3], eA1 = 0.5f * ps[3] + ps[4] + ps[5] + ps[6] + 0.5f * ps[7], eA2 = 0.5f * ps[7];
    const float eB0 = ps[8] + ps[9] + ps[10] + 0.5f * ps[11], eB1 = 0.5f * ps[11] + ps[12] + ps[13] + ps[14] + 0.5f * ps[15], eB2 = 0.5f * ps[15];
    const int bA = 8 * T + 2 * h, bB = bA + 4;
    if (j == 0 && h == 0) { row[bA] += eA0; row[bA + 1] += eA1; row[bA + 2] += eA2; row[bB] += eB0; row[bB + 1] += eB1; row[bB + 2] += eB2; }
    LDS_WAIT(); asm volatile("" ::: "memory");
    if (j == 0 && h == 1) { row[bA] += eA0; row[bA + 1] += eA1; row[bA + 2] += eA2; row[bB] += eB0; row[bB + 1] += eB1; row[bB + 2] += eB2; }
    LDS_WAIT(); asm volatile("" ::: "memory");
}
template <bool IMP, class MaskF>
__device__ __forceinline__ void nsa_branch(const bf16* kt, const bf16* vt, int dtstride, int T0, int T1, const bf16x8 (&qf)[8], const MaskF& mf, float gate, f32x16 (&o)[4], LAS float* improw, int j, int h) {
    float m = -1e30f, l = 0.f;
    for (int T = T0; T <= T1; ++T) { const unsigned allow = mf(T); if (!__any(allow != 0u)) continue;
        const f32x16 s = qk_tile<8>(kt + (size_t)T * 4096, qf); stat_update(m, l, s, allow); }
    l += shx<32>(l);
    const float inv = l > 0.f ? 1.0f / l : 0.f;
    for (int T = T0; T <= T1; ++T) { const unsigned allow = mf(T); if (!__any(allow != 0u)) continue;
        const f32x16 s = qk_tile<8>(kt + (size_t)T * 4096, qf);
        float pn[16];
#pragma unroll
        for (int i = 0; i < 16; ++i) pn[i] = ((allow >> i) & 1u) ? ex2(s[i] - m) * inv : 0.f;
        if (IMP) imp_accum(pn, T, j, h, improw);
        const bf16x8 pf0 = pack8(pn[0] * gate, pn[1] * gate, pn[2] * gate, pn[3] * gate, pn[4] * gate, pn[5] * gate, pn[6] * gate, pn[7] * gate);
        const bf16x8 pf1 = pack8(pn[8] * gate, pn[9] * gate, pn[10] * gate, pn[11] * gate, pn[12] * gate, pn[13] * gate, pn[14] * gate, pn[15] * gate);
        pv_tile(o, vt + (size_t)T * 1024, dtstride, pf0, pf1); }
}
__device__ __forceinline__ void nsa_unit(const Params& p, int u, LAS unsigned char* lds, int wave, int lane) {
    unsigned char* ws = p.ws;
    const int bg = u & 3, b = bg >> 1, g = bg & 1, pi = u >> 2;
    const int tb = (wave >> 2) ? 127 - pi : pi, t0w = 32 * tb + 8 * (wave & 3);
    const int c = lane & 31, h = lane >> 5, ti = c >> 2, j = c & 3, t = t0w + ti, head = 4 * g + j;
    const float* gt = (const float*)(ws + WS_GATES) + (size_t)(b * 4096 + t) * 24 + head * 3;
    const float g_c = gt[0], g_s = gt[1], g_w = gt[2];
    const bf16* nat = (const bf16*)(ws + WS_NAT);
    const bf16* qb = nat + (size_t)((16 + head) * 2 + b) * (4096 * 128);
    bf16x8 qf[8];
#pragma unroll
    for (int st = 0; st < 8; ++st) qf[st] = ldg8(qb + ((size_t)(((t >> 5) * 8 + st) * 64 + h * 32 + (t & 31))) * 8);
    f32x16 o[4];
#pragma unroll
    for (int dt = 0; dt < 4; ++dt)
#pragma unroll
        for (int i = 0; i < 16; ++i) o[dt][i] = 0.f;
    LAS float* imp = (LAS float*)(lds + wave * 2304);
    LAS unsigned* selm = (LAS unsigned*)(lds + 8 * 2304 + wave * 64);
    for (int i = lane; i < 8 * 68; i += 64) imp[i] = 0.f;
    LDS_WAIT(); asm volatile("" ::: "memory");
    {
        const int nv = t >= 31 ? ((t - 31) >> 4) + 1 : 0;
        const int nvmax = (t0w + 7) >= 31 ? ((t0w + 7 - 31) >> 4) + 1 : 0;
        const int NT = (nvmax + 31) >> 5;
        const bf16* kt = (const bf16*)(ws + WS_KC) + (size_t)(b * 2 + g) * (256 * 128) + lane * 8;
        const bf16* vt = (const bf16*)(ws + WS_VCT) + (size_t)(b * 2 + g) * (256 * 128) + lane * 8;
        auto mf = [=](int T) -> unsigned { return mask_le(32 * T + 8 * h, nv - 1); };
        nsa_branch<true>(kt, vt, 8 * 1024, 0, NT - 1, qf, mf, g_c, o, imp + ti * 68, j, h);
    }
    {
        const int tk = lane >> 3, sub = lane & 7, cur = t0w >> 6;
        const LAS float* row = imp + tk * 68;
        float sc[8]; int rank[8];
#pragma unroll
        for (int e = 0; e < 8; ++e) { const int mm = sub * 8 + e; const bool valid = mm <= cur, forced = (mm == 0) || (mm == cur) || (mm == cur - 1);
            sc[e] = valid ? (forced ? 3.0e38f : row[mm]) : -1.0f; rank[e] = 0; }
#pragma unroll 4
        for (int mp = 0; mp < 64; ++mp) { const bool validp = mp <= cur, forcedp = (mp == 0) || (mp == cur) || (mp == cur - 1);
            const float sp = validp ? (forcedp ? 3.0e38f : row[mp]) : -1.0f;
#pragma unroll
            for (int e = 0; e < 8; ++e) { const int mm = sub * 8 + e; rank[e] += ((sp > sc[e]) || (sp == sc[e] && mp < mm)) ? 1 : 0; } }
        unsigned byte = 0;
#pragma unroll
        for (int e = 0; e < 8; ++e) byte |= (unsigned)((sc[e] >= 0.f) && (rank[e] < 16)) << e;
        unsigned lo = sub < 4 ? byte << (8 * sub) : 0u, hi = sub >= 4 ? byte << (8 * (sub - 4)) : 0u;
        lo |= shxu<1>(lo); lo |= shxu<2>(lo); lo |= shxu<4>(lo);
        hi |= shxu<1>(hi); hi |= shxu<2>(hi); hi |= shxu<4>(hi);
        if (sub == 0) { selm[tk * 2] = lo; selm[tk * 2 + 1] = hi; }
        LDS_WAIT(); asm volatile("" ::: "memory");
    }
    const unsigned slo = selm[ti * 2], shi = selm[ti * 2 + 1];
    {
        const int cur = t0w >> 6;
        const bf16* kt = nat + (size_t)((28 + g) * 2 + b) * (4096 * 128) + lane * 8;
        const bf16* vt = (const bf16*)(ws + WS_VTT) + ((size_t)((8 + g) * 4) * 256 + b * 128) * 1024 + lane * 8;
        auto mf = [=](int T) -> unsigned { const int blk = T >> 1; const unsigned bit = blk < 32 ? (slo >> blk) & 1u : (shi >> (blk - 32)) & 1u;
            if (!bit) return 0u; return blk == cur ? mask_le(32 * T + 8 * h, t) : 0xFFFFu; };
        nsa_branch<false>(kt, vt, 256 * 1024, 0, 2 * cur + 1, qf, mf, g_s, o, imp, j, h);
    }
    {
        const int T0 = (t0w - 511 > 0 ? t0w - 511 : 0) >> 5, T1 = (t0w + 7) >> 5;
        const bf16* kt = nat + (size_t)((30 + g) * 2 + b) * (4096 * 128) + lane * 8;
        const bf16* vt = (const bf16*)(ws + WS_VTT) + ((size_t)((10 + g) * 4) * 256 + b * 128) * 1024 + lane * 8;
        auto mf = [=](int T) -> unsigned { const int kb = 32 * T + 8 * h; return mask_le(kb, t) & mask_ge(kb, t - 511); };
        nsa_branch<false>(kt, vt, 256 * 1024, T0, T1, qf, mf, g_w, o, imp, j, h);
    }
    bf16* op = (bf16*)(ws + WS_OATT) + (size_t)(b * 4096 + t) * DM + 1024 + head * 128 + 4 * h;
#pragma unroll
    for (int dt = 0; dt < 4; ++dt)
#pragma unroll
        for (int ig = 0; ig < 4; ++ig) { v2u w; w.x = cvtpk(o[dt][4 * ig], o[dt][4 * ig + 1]); w.y = cvtpk(o[dt][4 * ig + 2], o[dt][4 * ig + 3]); *(v2u*)(op + 32 * dt + 8 * ig) = w; }
}
__device__ __forceinline__ void diff_unit(const Params& p, int layer, int u, int wave, int lane) {
    unsigned char* ws = p.ws;
    const int bh = u & 15, b = bh >> 3, head = bh & 7, qi = u >> 4;
    const int qb128 = (wave >> 2) ? 31 - qi : qi, q0 = 128 * qb128 + 32 * (wave & 3);
    const int c = lane & 31, h = lane >> 5, t = q0 + c, Td = q0 >> 5;
    const bf16* nat = (const bf16*)(ws + WS_NAT);
    const bf16* qb = nat + (size_t)(head * 2 + b) * (4096 * 128);
    bf16x8 qf0[4], qf1[4];
#pragma unroll
    for (int st = 0; st < 4; ++st) { qf0[st] = ldg8(qb + ((size_t)(((t >> 5) * 8 + st) * 64 + h * 32 + (t & 31))) * 8); qf1[st] = ldg8(qb + ((size_t)(((t >> 5) * 8 + 4 + st) * 64 + h * 32 + (t & 31))) * 8); }
    const bf16* kt = nat + (size_t)((8 + head) * 2 + b) * (4096 * 128) + lane * 8;
    const bf16* vt = (const bf16*)(ws + WS_VTT) + ((size_t)(head * 4) * 256 + b * 128) * 1024 + lane * 8;
    float m0 = -1e30f, l0 = 0.f, m1 = -1e30f, l1 = 0.f;
    for (int T = 0; T <= Td; ++T) { const unsigned allow = T == Td ? mask_le(32 * T + 8 * h, t) : 0xFFFFu;
        const f32x16 s0 = qk_tile<4>(kt + (size_t)T * 4096, qf0); stat_update(m0, l0, s0, allow);
        const f32x16 s1 = qk_tile<4>(kt + (size_t)T * 4096 + 2048, qf1); stat_update(m1, l1, s1, allow); }
    l0 += shx<32>(l0); l1 += shx<32>(l1);
    const float* lm = (const float*)(ws + WS_LAM) + layer * 2;
    const float il0 = 1.0f / l0, il1 = lm[0] / l1;
    f32x16 o[4];
#pragma unroll
    for (int dt = 0; dt < 4; ++dt)
#pragma unroll
        for (int i = 0; i < 16; ++i) o[dt][i] = 0.f;
    for (int T = 0; T <= Td; ++T) { const unsigned allow = T == Td ? mask_le(32 * T + 8 * h, t) : 0xFFFFu;
        const f32x16 s0 = qk_tile<4>(kt + (size_t)T * 4096, qf0); const f32x16 s1 = qk_tile<4>(kt + (size_t)T * 4096 + 2048, qf1);
        float a[16];
#pragma unroll
        for (int i = 0; i < 16; ++i) a[i] = ((allow >> i) & 1u) ? ex2(s0[i] - m0) * il0 - ex2(s1[i] - m1) * il1 : 0.f;
        pv_tile(o, vt + (size_t)T * 1024, 256 * 1024, pack8(a[0], a[1], a[2], a[3], a[4], a[5], a[6], a[7]), pack8(a[8], a[9], a[10], a[11], a[12], a[13], a[14], a[15])); }
    float ss = 0.f;
#pragma unroll
    for (int dt = 0; dt < 4; ++dt)
#pragma unroll
        for (int i = 0; i < 16; ++i) ss += o[dt][i] * o[dt][i];
    ss += shx<32>(ss);
    const float r = rsqrtf(ss * (1.0f / 128.0f) + RMS_EPS) * lm[1];
    const float* sg = p.diff_subln + layer * 128 + 4 * h;
    bf16* op = (bf16*)(ws + WS_OATT) + (size_t)(b * 4096 + t) * DM + head * 128 + 4 * h;
#pragma unroll
    for (int dt = 0; dt < 4; ++dt)
#pragma unroll
        for (int ig = 0; ig < 4; ++ig) { const f32x4 gv = *(const f32x4*)(sg + 32 * dt + 8 * ig);
            v2u w; w.x = cvtpk(o[dt][4 * ig] * r * gv[0], o[dt][4 * ig + 1] * r * gv[1]); w.y = cvtpk(o[dt][4 * ig + 2] * r * gv[2], o[dt][4 * ig + 3] * r * gv[3]); *(v2u*)(op + 32 * dt + 8 * ig) = w; }
}
constexpr int ATT_STAGE = 32768, ATT_VOFF = 16384;
constexpr int ATT_NSTG = 4, ATT_PD = 3;
constexpr int ATT_EXTRA = 131072 + 1024;
constexpr int ATT_TBL = ATT_EXTRA + 8 * 2176 + 512;
constexpr int ATT_TBL_MAX = 192;
static_assert(ATT_TBL + ATT_TBL_MAX * 16 <= LDS_BYTES, "attention LDS map");
__device__ __forceinline__ void att_bar() { asm volatile("s_waitcnt vmcnt(0) lgkmcnt(0)\n\ts_barrier" ::: "memory"); }
template <int C> __device__ __forceinline__ void att_wait_tile(int after) {
    static_assert(C == 3 || C == 4, "DMA instructions per wave per tile");
    if (after >= 2) { if (C == 3) asm volatile("s_waitcnt vmcnt(6) lgkmcnt(0)\n\ts_barrier" ::: "memory"); else asm volatile("s_waitcnt vmcnt(8) lgkmcnt(0)\n\ts_barrier" ::: "memory"); }
    else if (after == 1) { if (C == 3) asm volatile("s_waitcnt vmcnt(3) lgkmcnt(0)\n\ts_barrier" ::: "memory"); else asm volatile("s_waitcnt vmcnt(4) lgkmcnt(0)\n\ts_barrier" ::: "memory"); }
    else asm volatile("s_waitcnt vmcnt(0) lgkmcnt(0)\n\ts_barrier" ::: "memory");
}
__device__ __forceinline__ void dma_frag(const unsigned char* gsrc_uniform, unsigned lane16, LAS unsigned char* dst) {
    const unsigned long long a_ = (unsigned long long)gsrc_uniform;
    const unsigned d_ = (unsigned)(unsigned long long)dst;
    unsigned keep;
    asm volatile("s_mov_b32 %0, m0\n\ts_mov_b32 m0, %3\n\ts_nop 0\n\tglobal_load_lds_dwordx4 %1, %2\n\ts_mov_b32 m0, %0" : "=&s"(keep) : "v"(lane16), "s"(a_), "s"(d_) : "memory");
}
__device__ __forceinline__ v4u att_desc(const LAS unsigned char* lds, int i) {
    const v4u d = *(const LAS v4u*)(lds + ATT_TBL + i * 16);
    v4u r; r.x = __builtin_amdgcn_readfirstlane(d.x); r.y = __builtin_amdgcn_readfirstlane(d.y); r.z = __builtin_amdgcn_readfirstlane(d.z); r.w = 0u; return r;
}
__device__ __forceinline__ unsigned m32_le(int kb, int lim) { unsigned r = 0;
#pragma unroll
    for (int q = 0; q < 32; ++q) r |= (unsigned)((kb + 32 * (q >> 4) + (q & 7) + 16 * ((q >> 3) & 1)) <= lim) << q;
    return r; }
__device__ __forceinline__ unsigned m32_ge(int kb, int lim) { unsigned r = 0;
#pragma unroll
    for (int q = 0; q < 32; ++q) r |= (unsigned)((kb + 32 * (q >> 4) + (q & 7) + 16 * ((q >> 3) & 1)) >= lim) << q;
    return r; }
template <int NQK>
__device__ __forceinline__ f32x16 qk32(const LAS unsigned char* stg, int sub, const bf16x8 (&qf)[NQK], int lane) {
    const LAS unsigned char* kp = stg + sub * (NQK * 1024) + lane * 16;
    f32x16 s;
#pragma unroll
    for (int i = 0; i < 16; ++i) s[i] = 0.f;
    bf16x8 kf[NQK];
#pragma unroll
    for (int st = 0; st < NQK; ++st) kf[st] = *(const LAS bf16x8*)(kp + st * 1024);
    asm volatile("s_waitcnt lgkmcnt(0)" ::: "memory"); __builtin_amdgcn_sched_barrier(0);
#pragma unroll
    for (int st = 0; st < NQK; ++st) s = MFMA32(kf[st], qf[st], s);
    return s;
}
__device__ __forceinline__ void pv32(f32x16 (&o)[4], const LAS unsigned char* stg, int sub, const bf16x8 pf0, const bf16x8 pf1, int lane) {
    const LAS unsigned char* vp = stg + ATT_VOFF + sub * 2048 + lane * 16;
    bf16x8 vf[8];
#pragma unroll
    for (int dt = 0; dt < 4; ++dt) { vf[2 * dt] = *(const LAS bf16x8*)(vp + dt * 4096); vf[2 * dt + 1] = *(const LAS bf16x8*)(vp + dt * 4096 + 1024); }
    asm volatile("s_waitcnt lgkmcnt(0)" ::: "memory"); __builtin_amdgcn_sched_barrier(0);
#pragma unroll
    for (int dt = 0; dt < 4; ++dt) { o[dt] = MFMA32(vf[2 * dt], pf0, o[dt]); o[dt] = MFMA32(vf[2 * dt + 1], pf1, o[dt]); }
}
__device__ __forceinline__ void online32(float& m, float& l, f32x16 (&o)[4], f32x16& s, unsigned allow, bf16x8& pf0, bf16x8& pf1) {
    const bool full = __all(allow == 0xFFFFu);
    float tm = -1e30f;
    if (full) {
#pragma unroll
        for (int i = 0; i < 16; ++i) tm = fmaxf(tm, s[i]);
    } else {
#pragma unroll
        for (int i = 0; i < 16; ++i) tm = fmaxf(tm, ((allow >> i) & 1u) ? s[i] : -1e30f);
    }
    tm = fmaxf(tm, shx<32>(tm));
    const float mn = fmaxf(m, tm);
    if (!__all(mn == m)) { const float alpha = ex2(m - mn); l *= alpha; m = mn;
#pragma unroll
        for (int dt = 0; dt < 4; ++dt)
#pragma unroll
            for (int i = 0; i < 16; ++i) o[dt][i] *= alpha; }
    float a = 0.f;
    if (full) {
#pragma unroll
        for (int i = 0; i < 16; ++i) { s[i] = ex2(s[i] - m); a += s[i]; }
    } else {
#pragma unroll
        for (int i = 0; i < 16; ++i) { s[i] = ((allow >> i) & 1u) ? ex2(s[i] - m) : 0.f; a += s[i]; }
    }
    l += a;
    pf0 = pack8(s[0], s[1], s[2], s[3], s[4], s[5], s[6], s[7]); pf1 = pack8(s[8], s[9], s[10], s[11], s[12], s[13], s[14], s[15]);
}
#define ATT_PIN() do { asm volatile("s_waitcnt lgkmcnt(0)" ::: "memory"); __builtin_amdgcn_sched_barrier(0); } while (0)
template <int NQK>
__device__ __forceinline__ void tile64_online(const LAS unsigned char* stg, const bf16x8 (&qf)[NQK], unsigned allow, float& m, float& l, f32x16 (&o)[4], int lane) {
    const LAS unsigned char* kp = stg + lane * 16;
    const LAS unsigned char* vp = stg + ATT_VOFF + lane * 16;
    f32x16 s0, s1;
#pragma unroll
    for (int i = 0; i < 16; ++i) { s0[i] = 0.f; s1[i] = 0.f; }
    {   bf16x8 kf[NQK];
#pragma unroll
        for (int st = 0; st < NQK; ++st) kf[st] = *(const LAS bf16x8*)(kp + st * 1024);
        ATT_PIN();
#pragma unroll
        for (int st = 0; st < NQK; ++st) s0 = MFMA32(kf[st], qf[st], s0);
        __builtin_amdgcn_sched_barrier(0);
#pragma unroll
        for (int st = 0; st < NQK; ++st) kf[st] = *(const LAS bf16x8*)(kp + (NQK + st) * 1024);
        ATT_PIN();
#pragma unroll
        for (int st = 0; st < NQK; ++st) s1 = MFMA32(kf[st], qf[st], s1);
        __builtin_amdgcn_sched_barrier(0);
    }
    bf16x8 vf[8];
#pragma unroll
    for (int dt = 0; dt < (NQK == 4 ? 4 : 2); ++dt) { vf[2 * dt] = *(const LAS bf16x8*)(vp + dt * 4096); vf[2 * dt + 1] = *(const LAS bf16x8*)(vp + dt * 4096 + 1024); }
    __builtin_amdgcn_sched_barrier(0);
    const bool full = __all(allow == 0xFFFFFFFFu);
    float tm = -1e30f;
    if (full) {
#pragma unroll
        for (int i = 0; i < 16; ++i) { tm = fmaxf(tm, s0[i]); tm = fmaxf(tm, s1[i]); }
    } else {
#pragma unroll
        for (int i = 0; i < 16; ++i) { tm = fmaxf(tm, ((allow >> i) & 1u) ? s0[i] : -1e30f); tm = fmaxf(tm, ((allow >> (16 + i)) & 1u) ? s1[i] : -1e30f); }
    }
    tm = fmaxf(tm, shx<32>(tm));
    const float mn = fmaxf(m, tm);
    if (!__all(mn == m)) { const float alpha = ex2(m - mn); l *= alpha; m = mn;
#pragma unroll
        for (int dt = 0; dt < 4; ++dt)
#pragma unroll
            for (int i = 0; i < 16; ++i) o[dt][i] *= alpha; }
    float a = 0.f;
    if (full) {
#pragma unroll
        for (int i = 0; i < 16; ++i) { s0[i] = ex2(s0[i] - m); a += s0[i]; }
    } else {
#pragma unroll
        for (int i = 0; i < 16; ++i) { s0[i] = ((allow >> i) & 1u) ? ex2(s0[i] - m) : 0.f; a += s0[i]; }
    }
    { const bf16x8 pf0 = pack8(s0[0], s0[1], s0[2], s0[3], s0[4], s0[5], s0[6], s0[7]), pf1 = pack8(s0[8], s0[9], s0[10], s0[11], s0[12], s0[13], s0[14], s0[15]);
      if (NQK != 4) {
#pragma unroll
          for (int dt = 2; dt < 4; ++dt) { vf[2 * dt] = *(const LAS bf16x8*)(vp + dt * 4096); vf[2 * dt + 1] = *(const LAS bf16x8*)(vp + dt * 4096 + 1024); } }
      ATT_PIN();
#pragma unroll
      for (int dt = 0; dt < 4; ++dt) { o[dt] = MFMA32(vf[2 * dt], pf0, o[dt]); o[dt] = MFMA32(vf[2 * dt + 1], pf1, o[dt]); } }
    __builtin_amdgcn_sched_barrier(0);
#pragma unroll
    for (int dt = 0; dt < 4; ++dt) { vf[2 * dt] = *(const LAS bf16x8*)(vp + 2048 + dt * 4096); vf[2 * dt + 1] = *(const LAS bf16x8*)(vp + 2048 + dt * 4096 + 1024); }
    __builtin_amdgcn_sched_barrier(0);
    if (full) {
#pragma unroll
        for (int i = 0; i < 16; ++i) { s1[i] = ex2(s1[i] - m); a += s1[i]; }
    } else {
#pragma unroll
        for (int i = 0; i < 16; ++i) { s1[i] = ((allow >> (16 + i)) & 1u) ? ex2(s1[i] - m) : 0.f; a += s1[i]; }
    }
    l += a;
    { const bf16x8 pf0 = pack8(s1[0], s1[1], s1[2], s1[3], s1[4], s1[5], s1[6], s1[7]), pf1 = pack8(s1[8], s1[9], s1[10], s1[11], s1[12], s1[13], s1[14], s1[15]);
      ATT_PIN();
#pragma unroll
      for (int dt = 0; dt < 4; ++dt) { o[dt] = MFMA32(vf[2 * dt], pf0, o[dt]); o[dt] = MFMA32(vf[2 * dt + 1], pf1, o[dt]); } }
    __builtin_amdgcn_sched_barrier(0);
}
__device__ __forceinline__ void stash_store(float* scr, const f32x16 (&o)[4], float scale, int lane) {
    float* sp = scr + lane;
#pragma unroll
    for (int dt = 0; dt < 4; ++dt)
#pragma unroll
        for (int i = 0; i < 16; ++i) sp[(dt * 16 + i) * 64] = o[dt][i] * scale;
}
__device__ __forceinline__ void diff_engine(const Params& p, int layer, int u, LAS unsigned char* lds, int bid, int wave, int lane) {
    unsigned char* ws = p.ws;
    const int bh = u & 15, b = bh >> 3, head = bh & 7, qi = u >> 4;
    const int qb128 = (wave >> 2) ? 31 - qi : qi, qw = 128 * qb128 + 32 * (wave & 3);
    const int c = lane & 31, h = lane >> 5, t = qw + c;
    const bf16* qb = (const bf16*)(ws + WS_NAT) + (size_t)(head * 2 + b) * (4096 * 128);
    const size_t kbase_b = WS_NAT + ((size_t)((8 + head) * 2 + b) * (4096 * 128)) * 2;
    const size_t vbase_b = WS_VTT + (((size_t)(head * 4) * 256 + b * 128) * 1024) * 2;
    const unsigned lane16 = (unsigned)lane * 16u;
    float* scr = (float*)(ws + WS_SCR) + (size_t)(bid * NWAVES + wave) * 4096;
    const int NT = 2 * (32 - qi), NS = 2 * NT;
    att_bar();
    for (int i = wave * 64 + lane; i < NS; i += NWAVES * 64) { const int cc = i >= NT ? 1 : 0, T = i - cc * NT;
        v4u d; d.x = (unsigned)(kbase_b + ((size_t)((2 * T) * 8 + 4 * cc) * 512) * 2); d.y = (unsigned)(vbase_b + ((size_t)T * 2048) * 2); d.z = 256u * 1024u * 2u; d.w = 0u;
        *(LAS v4u*)(lds + ATT_TBL + i * 16) = d; }
    att_bar();
    auto issue = [&](int i) {
        const v4u d = att_desc(lds, i);
        LAS unsigned char* stg = lds + (i & (ATT_NSTG - 1)) * ATT_STAGE;
#pragma unroll
        for (int k = 0; k < 3; ++k) { const int f = 3 * wave + k;
            if (f < 8) dma_frag(ws + d.x + ((f >> 2) * 4096 + (f & 3) * 512) * 2, lane16, stg + f * 1024);
            else { const int v = f - 8; dma_frag(ws + d.y + (size_t)(v >> 2) * d.z + (v & 3) * 1024, lane16, stg + ATT_VOFF + v * 1024); } }
    };
    const float* lm = (const float*)(ws + WS_LAM) + layer * 2;
    int step = 0;
    issue(0); issue(1); issue(2);
#pragma unroll 1
    for (int cc = 0; cc < 2; ++cc) {
        bf16x8 qf[4]; f32x16 o[4]; float m = -1e30f, l = 0.f;
        {
            int tq = t, hq = h; asm volatile("" : "+v"(tq), "+v"(hq));
#pragma unroll
            for (int st = 0; st < 4; ++st) qf[st] = ldg8(qb + ((size_t)(((tq >> 5) * 8 + 4 * cc + st) * 64 + hq * 32 + (tq & 31))) * 8);
            asm volatile("s_waitcnt vmcnt(0)" : "+v"(qf[0]), "+v"(qf[1]), "+v"(qf[2]), "+v"(qf[3]));
#pragma unroll
            for (int dt = 0; dt < 4; ++dt)
#pragma unroll
                for (int i = 0; i < 16; ++i) o[dt][i] = 0.f;
        }
#pragma unroll 1
        for (int T = 0; T < NT; ++T, ++step) {
            att_wait_tile<3>(NS - 1 - step);
            if (step + ATT_PD < NS) issue(step + ATT_PD);
            if (64 * T <= qw + 31) {
                const LAS unsigned char* stg = lds + (step & (ATT_NSTG - 1)) * ATT_STAGE;
                const unsigned allow = (64 * T + 63 > qw) ? m32_le(64 * T + 8 * h, t) : 0xFFFFFFFFu;
                tile64_online<4>(stg, qf, allow, m, l, o, lane);
            }
        }
        {
            int ll = lane, tt = t; asm volatile("" : "+v"(ll), "+v"(tt));
            l += shx<32>(l);
            if (cc == 0) stash_store(scr, o, 1.0f / l, ll);
            else {
                const float il1 = lm[0] / l;
                float ss = 0.f;
#pragma unroll
                for (int dt = 0; dt < 4; ++dt)
#pragma unroll
                    for (int i = 0; i < 16; ++i) { const float v = (scr + ll)[(dt * 16 + i) * 64] - o[dt][i] * il1; o[dt][i] = v; ss += v * v; }
                ss += shx<32>(ss);
                const float r = rsqrtf(ss * (1.0f / 128.0f) + RMS_EPS) * lm[1];
                const int hh2 = ll >> 5;
                const float* sg = p.diff_subln + layer * 128 + 4 * hh2;
                bf16* op = (bf16*)(ws + WS_OATT) + (size_t)(b * 4096 + tt) * DM + head * 128 + 4 * hh2;
#pragma unroll
                for (int dt = 0; dt < 4; ++dt)
#pragma unroll
                    for (int ig = 0; ig < 4; ++ig) { const f32x4 gv = *(const f32x4*)(sg + 32 * dt + 8 * ig);
                        v2u w; w.x = cvtpk(o[dt][4 * ig] * r * gv[0], o[dt][4 * ig + 1] * r * gv[1]); w.y = cvtpk(o[dt][4 * ig + 2] * r * gv[2], o[dt][4 * ig + 3] * r * gv[3]); *(v2u*)(op + 32 * dt + 8 * ig) = w; }
            }
        }
    }
    att_bar();
}
__device__ __forceinline__ void nsa_engine(const Params& p, int u, LAS unsigned char* lds, int bid, int wave, int lane) {
    unsigned char* ws = p.ws;
    const int bg = u & 3, b = bg >> 1, g = bg & 1, pi = u >> 2;
    const int tb = (wave >> 2) ? 127 - pi : pi, t0w = 32 * tb + 8 * (wave & 3);
    const int c = lane & 31, h = lane >> 5, ti = c >> 2, j = c & 3, t = t0w + ti, head = 4 * g + j;
    const float* gt = (const float*)(ws + WS_GATES) + (size_t)(b * 4096 + t) * 24 + head * 3;
    float g_c = gt[0], g_s = gt[1], g_w = gt[2];
    asm volatile("s_waitcnt vmcnt(0)" : "+v"(g_c), "+v"(g_s), "+v"(g_w));
    const bf16* qb = (const bf16*)(ws + WS_NAT) + (size_t)((16 + head) * 2 + b) * (4096 * 128);
    bf16x8 qf[8];
#pragma unroll
    for (int st = 0; st < 8; ++st) qf[st] = ldg8(qb + ((size_t)(((t >> 5) * 8 + st) * 64 + h * 32 + (t & 31))) * 8);
    asm volatile("s_waitcnt vmcnt(0)" : "+v"(qf[0]), "+v"(qf[1]), "+v"(qf[2]), "+v"(qf[3]), "+v"(qf[4]), "+v"(qf[5]), "+v"(qf[6]), "+v"(qf[7]));
    float* scr = (float*)(ws + WS_SCR) + (size_t)(bid * NWAVES + wave) * 4096;
    LAS float* imp = (LAS float*)(lds + ATT_EXTRA + wave * 2176);
    LAS unsigned* selm = (LAS unsigned*)(lds + ATT_EXTRA + 8 * 2176 + wave * 64);
    const unsigned lane16 = (unsigned)lane * 16u;
    const int tA = 32 * pi, tB = 32 * (127 - pi);
    const int nvB = (tB >> 4) + 1;
    const int NTc = (nvB + 63) >> 6;
    const int curB = tB >> 6, NSel = curB + 1;
    const int wA0 = (tA - 511 > 0 ? tA - 511 : 0) >> 6, wA1 = (tA + 31) >> 6, wB0 = (tB - 511) >> 6, wB1 = (tB + 31) >> 6;
    const int gap = wB0 > wA1 + 1 ? wB0 - (wA1 + 1) : 0;
    const int NWin = (wB1 - wA0 + 1) - gap;
    const int n1 = 2 * NTc, n2 = n1 + NSel, NS = n2 + NWin;
    auto win_tile = [&](int k) -> int { int w = wA0 + k; if (w > wA1) w += gap; return w; };
    att_bar();
    for (int i = lane; i < 8 * 68; i += 64) imp[i] = 0.f;
    for (int i = wave * 64 + lane; i < NS; i += NWAVES * 64) {
        size_t kb_, vb_; unsigned vdt; int T;
        if (i < n1) { T = i < NTc ? i : i - NTc; kb_ = WS_KC + ((size_t)(b * 2 + g) * (256 * 128)) * 2; vb_ = WS_VCT + ((size_t)(b * 2 + g) * (256 * 128)) * 2; vdt = 8192u * 2u; }
        else { const bool sel = i < n2; T = sel ? i - n1 : win_tile(i - n2);
            kb_ = WS_NAT + ((size_t)(((sel ? 28 : 30) + g) * 2 + b) * (4096 * 128)) * 2; vb_ = WS_VTT + (((size_t)(((sel ? 8 : 10) + g) * 4) * 256 + b * 128) * 1024) * 2; vdt = 256u * 1024u * 2u; }
        v4u d; d.x = (unsigned)(kb_ + ((size_t)T * 8192) * 2); d.y = (unsigned)(vb_ + ((size_t)T * 2048) * 2); d.z = vdt; d.w = 0u;
        *(LAS v4u*)(lds + ATT_TBL + i * 16) = d; }
    att_bar();
    auto issue = [&](int i) {
        const v4u d = att_desc(lds, i);
        LAS unsigned char* stg = lds + (i & (ATT_NSTG - 1)) * ATT_STAGE;
        if (wave < 4) {
#pragma unroll
            for (int k = 0; k < 4; ++k) dma_frag(ws + d.x + (4 * wave + k) * 1024, lane16, stg + (4 * wave + k) * 1024);
        } else { const int dt = wave - 4;
#pragma unroll
            for (int k = 0; k < 4; ++k) dma_frag(ws + d.y + (size_t)dt * d.z + k * 1024, lane16, stg + ATT_VOFF + (dt * 4 + k) * 1024); }
    };
    const int nv = t >= 31 ? ((t - 31) >> 4) + 1 : 0, cur = t0w >> 6;
    f32x16 o[4]; float m = -1e30f, l = 0.f, inv_c = 0.f; unsigned slo = 0u, shi = 0u;
    int step = 0;
    issue(0); issue(1); issue(2);
#pragma unroll 1
    for (int T = 0; T < NTc; ++T, ++step) {
        att_wait_tile<4>(NS - 1 - step);
        if (step + ATT_PD < NS) issue(step + ATT_PD);
        const LAS unsigned char* stg = lds + (step & (ATT_NSTG - 1)) * ATT_STAGE;
        const unsigned allow = m32_le(64 * T + 8 * h, nv - 1);
        if (__any(allow != 0u)) {
#pragma unroll 1
            for (int sub = 0; sub < 2; ++sub) { const unsigned al = (allow >> (16 * sub)) & 0xFFFFu;
                const f32x16 s = qk32<8>(stg, sub, qf, lane);
                float tm = -1e30f;
#pragma unroll
                for (int i = 0; i < 16; ++i) tm = fmaxf(tm, ((al >> i) & 1u) ? s[i] : -1e30f);
                tm = fmaxf(tm, shx<32>(tm));
                const float mn = fmaxf(m, tm); float a = 0.f;
#pragma unroll
                for (int i = 0; i < 16; ++i) a += ((al >> i) & 1u) ? ex2(s[i] - mn) : 0.f;
                l = l * ex2(m - mn) + a; m = mn;
                __builtin_amdgcn_sched_barrier(0); } }
    }
    l += shx<32>(l); inv_c = l > 0.f ? 1.0f / l : 0.f;
#pragma unroll
    for (int dt = 0; dt < 4; ++dt)
#pragma unroll
        for (int i = 0; i < 16; ++i) o[dt][i] = 0.f;
#pragma unroll 1
    for (int T = 0; T < NTc; ++T, ++step) {
        att_wait_tile<4>(NS - 1 - step);
        if (step + ATT_PD < NS) issue(step + ATT_PD);
        const LAS unsigned char* stg = lds + (step & (ATT_NSTG - 1)) * ATT_STAGE;
        const unsigned allow = m32_le(64 * T + 8 * h, nv - 1);
        if (__any(allow != 0u)) {
#pragma unroll 1
            for (int sub = 0; sub < 2; ++sub) { const unsigned al = (allow >> (16 * sub)) & 0xFFFFu;
                const f32x16 s = qk32<8>(stg, sub, qf, lane);
                float pn[16];
#pragma unroll
                for (int i = 0; i < 16; ++i) pn[i] = ((al >> i) & 1u) ? ex2(s[i] - m) * inv_c : 0.f;
                imp_accum(pn, 2 * T + sub, j, h, imp + ti * 68);
                const bf16x8 pf0 = pack8(pn[0] * g_c, pn[1] * g_c, pn[2] * g_c, pn[3] * g_c, pn[4] * g_c, pn[5] * g_c, pn[6] * g_c, pn[7] * g_c);
                const bf16x8 pf1 = pack8(pn[8] * g_c, pn[9] * g_c, pn[10] * g_c, pn[11] * g_c, pn[12] * g_c, pn[13] * g_c, pn[14] * g_c, pn[15] * g_c);
                pv32(o, stg, sub, pf0, pf1, lane);
                __builtin_amdgcn_sched_barrier(0); } }
    }
    {
        int ll = lane; asm volatile("" : "+v"(ll));
        stash_store(scr, o, 1.0f, ll);
        const int tk = ll >> 3, sub = ll & 7;
        const LAS float* row = imp + tk * 68;
        float sc[8]; int rank[8];
#pragma unroll
        for (int e = 0; e < 8; ++e) { const int mm = sub * 8 + e; const bool valid = mm <= cur, forced = (mm == 0) || (mm == cur) || (mm == cur - 1);
            sc[e] = valid ? (forced ? 3.0e38f : row[mm]) : -1.0f; rank[e] = 0; }
#pragma unroll 4
        for (int mp = 0; mp < 64; ++mp) { const bool validp = mp <= cur, forcedp = (mp == 0) || (mp == cur) || (mp == cur - 1);
            const float sp = validp ? (forcedp ? 3.0e38f : row[mp]) : -1.0f;
#pragma unroll
            for (int e = 0; e < 8; ++e) { const int mm = sub * 8 + e; rank[e] += ((sp > sc[e]) || (sp == sc[e] && mp < mm)) ? 1 : 0; } }
        unsigned byte = 0;
#pragma unroll
        for (int e = 0; e < 8; ++e) byte |= (unsigned)((sc[e] >= 0.f) && (rank[e] < 16)) << e;
        unsigned lo = sub < 4 ? byte << (8 * sub) : 0u, hi = sub >= 4 ? byte << (8 * (sub - 4)) : 0u;
        lo |= shxu<1>(lo); lo |= shxu<2>(lo); lo |= shxu<4>(lo);
        hi |= shxu<1>(hi); hi |= shxu<2>(hi); hi |= shxu<4>(hi);
        if (sub == 0) { selm[tk * 2] = lo; selm[tk * 2 + 1] = hi; }
        LDS_WAIT(); asm volatile("" ::: "memory");
        { const int ti2 = (ll & 31) >> 2; slo = selm[ti2 * 2]; shi = selm[ti2 * 2 + 1]; }
    }
    auto reset = [&]() { m = -1e30f; l = 0.f;
#pragma unroll
        for (int dt = 0; dt < 4; ++dt)
#pragma unroll
            for (int i = 0; i < 16; ++i) o[dt][i] = 0.f; };
    auto tile = [&](const LAS unsigned char* stg, unsigned allow) {
        if (__any(allow != 0u)) tile64_online<8>(stg, qf, allow, m, l, o, lane); };
    reset();
#pragma unroll 1
    for (int T = 0; T < NSel; ++T, ++step) {
        att_wait_tile<4>(NS - 1 - step);
        if (step + ATT_PD < NS) issue(step + ATT_PD);
        const unsigned bit = T < 32 ? (slo >> T) & 1u : (shi >> (T - 32)) & 1u;
        const unsigned allow = bit ? (T == cur ? m32_le(64 * T + 8 * h, t) : 0xFFFFFFFFu) : 0u;
        tile(lds + (step & (ATT_NSTG - 1)) * ATT_STAGE, allow);
    }
    {
        int ll = lane; asm volatile("" : "+v"(ll));
        l += shx<32>(l);
        const float sc = g_s / l;
        float* sp = scr + ll;
#pragma unroll
        for (int dt = 0; dt < 4; ++dt)
#pragma unroll
            for (int i = 0; i < 16; ++i) sp[(dt * 16 + i) * 64] += o[dt][i] * sc;
    }
    reset();
#pragma unroll 1
    for (int k = 0; k < NWin; ++k, ++step) {
        att_wait_tile<4>(NS - 1 - step);
        if (step + ATT_PD < NS) issue(step + ATT_PD);
        const int T = win_tile(k);
        const unsigned allow = (64 * T + 63 >= t0w - 511 && 64 * T <= t0w + 7) ? (m32_le(64 * T + 8 * h, t) & m32_ge(64 * T + 8 * h, t - 511)) : 0u;
        tile(lds + (step & (ATT_NSTG - 1)) * ATT_STAGE, allow);
    }
    {
        int ll = lane, tt = t; asm volatile("" : "+v"(ll), "+v"(tt));
        l += shx<32>(l);
        const float sc = g_w / l;
        const float* sp = scr + ll;
        bf16* op = (bf16*)(ws + WS_OATT) + (size_t)(b * 4096 + tt) * DM + 1024 + (4 * g + (ll & 3)) * 128 + 4 * (ll >> 5);
#pragma unroll
        for (int dt = 0; dt < 4; ++dt)
#pragma unroll
            for (int ig = 0; ig < 4; ++ig) { float v[4];
#pragma unroll
                for (int e = 0; e < 4; ++e) v[e] = sp[(dt * 16 + 4 * ig + e) * 64] + o[dt][4 * ig + e] * sc;
                v2u w; w.x = cvtpk(v[0], v[1]); w.y = cvtpk(v[2], v[3]); *(v2u*)(op + 32 * dt + 8 * ig) = w; }
    }
    att_bar();
}
#define LAUNDER_V(x) asm volatile("" : "+v"(x))
#define LAUNDER_S(x) asm volatile("" : "+s"(x))
template <int PH>
__device__ __forceinline__ void run_phase(int it, LAS unsigned char* lds, int wave_s, int rep = 0) {
    const __attribute__((address_space(4))) Params* pp_ = (const __attribute__((address_space(4))) Params*)__builtin_amdgcn_kernarg_segment_ptr(); LAUNDER_S(pp_);
#if defined(__HIP_DEVICE_COMPILE__)
    const Params p = *pp_;
#else
    const Params p{};
#endif
    int wv_ = wave_s; LAUNDER_S(wv_);
    int ln_; asm volatile("v_mbcnt_lo_u32_b32 %0, -1, 0\n\tv_mbcnt_hi_u32_b32 %0, -1, %0" : "=v"(ln_));
    int tid = wv_ * 64 + ln_;
    int bid = blockIdx.x, G = gridDim.x; LAUNDER_S(bid); LAUNDER_S(G);
    unsigned char* ws = p.ws; LAUNDER_S(ws);
    const int lane = tid & 63, wave = __builtin_amdgcn_readfirstlane(tid >> 6), gw = bid * NWAVES + wave, NGW = G * NWAVES;
    const int l = it >> 1, f = it & 1, sub = f ? 2 : 0;
    const float* modl = (const float*)(ws + WS_MOD) + (size_t)l * 2 * NMOD * DM;
    bf16* const H = (bf16*)(ws + WS_H); bf16* const ACT = (bf16*)(ws + WS_ACT); bf16* const OATT = (bf16*)(ws + WS_OATT);
    float* const X = p.out;
    if constexpr (PH == 8) prologue(p, lds, bid, G, tid, wave, lane);
    if constexpr (PH == 9) final_norm_phase(X, p.final_g, gw, NGW, lane);
    if constexpr (PH == 0) norm_phase(X, p.norm_g + (size_t)(l * 3 + sub) * DM, modl + (3 * sub) * DM, modl + (3 * sub + 1) * DM, (size_t)NMOD * DM, H, gw, NGW, lane);
    if constexpr (PH == 3) norm_phase(X, p.norm_g + (size_t)(l * 3 + 1) * DM, modl + 3 * DM, modl + 4 * DM, (size_t)NMOD * DM, H, gw, NGW, lane);
    if constexpr (PH == 1) {
        pg8::Gemm g{H, (const bf16*)(ws + WS_WGU) + (size_t)(l * 2 + f) * NGU * DM, MTOK, NGU, DM}; pg8::StaticOrder S; S.init(MTOK, NGU, G, bid);
        pg8::EpiSwiglu E{ACT, DFF};
        pg8::gemm_phase<pg8::EpiSwiglu, pg8::StaticOrder, PG8_ALIGN, PG8_SP2>(lds + RING_OFF, g, S, E, tid);
    }
    if constexpr (PH == 2) {
        pg8::Gemm g{ACT, (const bf16*)(ws + WS_WD) + (size_t)(l * 2 + f) * DM * DFF, MTOK, DM, DFF}; pg8::StaticOrder S; S.init(MTOK, DM, G, bid);
        pg8::EpiResid E{X, modl + (3 * sub + 2) * DM, NMOD * DM, rep ? 0.0f : 0.5f};
        pg8::gemm_phase<pg8::EpiResid, pg8::StaticOrder, PG8_ALIGN, PG8_SP2>(lds + RING_OFF, g, S, E, tid);
    }
    if constexpr (PH == 4) {
        { pg8::Gemm g{H, (const bf16*)(ws + WS_WNAT) + (size_t)l * NATN * DM, MTOK, NATN, DM}; pg8::StaticOrder S; S.init(MTOK, NATN, G, bid);
          pg8::EpiNat E{(bf16*)(ws + WS_NAT), (float*)(ws + WS_GATES), (const float*)(ws + WS_ROPE), 0.125f * LOG2E, 0.08838834764831845f * LOG2E, (bf16*)(ws + WS_KVC)};
          pg8::gemm_phase<pg8::EpiNat, pg8::StaticOrder, PG8_ALIGN, PG8_SP2>(lds + RING_OFF, g, S, E, tid); }
        { pg8::Gemm g{(const bf16*)(ws + WS_WV) + (size_t)l * VTN * DM, H, VTN, MTOK, DM}; pg8::StaticOrder S; S.init(VTN, MTOK, G, G - 1 - bid);
          pg8::EpiVT E{(bf16*)(ws + WS_VTT)};
          pg8::gemm_phase<pg8::EpiVT, pg8::StaticOrder, PG8_ALIGN, PG8_SP2>(lds + RING_OFF, g, S, E, tid); }
    }
    if constexpr (PH == 5) {
#ifndef REP5
#define REP5 0
#endif
        for (int r5 = 0; r5 < 1 + (REP5 & 1); ++r5)
        for (int u = bid; u < 128; u += G) compress_unit(p, l, u, lds, tid, wave, lane);
#if ATTN_V2
        for (int r5 = 0; r5 < 1 + ((REP5 >> 1) & 1); ++r5)
        for (int u = bid; u < 256; u += G) diff_engine(p, l, u, lds, bid, wave, lane);
#else
        for (int u = bid; u < 256; u += G) diff_unit(p, l, u, wave, lane);
#endif
    }
#if ATTN_V2
    if constexpr (PH == 6) { for (int u = bid; u < 256; u += G) nsa_engine(p, u, lds, bid, wave, lane); }
#else
    if constexpr (PH == 6) { for (int u = bid; u < 256; u += G) nsa_unit(p, u, lds, wave, lane); }
#endif
    if constexpr (PH == 7) {
        pg8::Gemm g{OATT, (const bf16*)(ws + WS_WO) + (size_t)l * DM * DM, MTOK, DM, DM}; pg8::StaticOrder S; S.init(MTOK, DM, G, bid);
        pg8::EpiResid E{X, modl + 5 * DM, NMOD * DM, rep ? 0.0f : 1.0f};
        pg8::gemm_phase<pg8::EpiResid, pg8::StaticOrder, PG8_ALIGN, PG8_SP2>(lds + RING_OFF, g, S, E, tid);
    }
}
template <int PH>
__global__ void __launch_bounds__(NWAVES * 64, 2) phase_kernel(Params p) {
    extern __shared__ __attribute__((aligned(16))) unsigned char lds_raw[];
    run_phase<PH>(p.one_it, (LAS unsigned char*)lds_raw, __builtin_amdgcn_readfirstlane(threadIdx.x >> 6));
}
__global__ void __launch_bounds__(NWAVES * 64, 2) mega_fwd(Params p) {
    extern __shared__ __attribute__((aligned(16))) unsigned char lds_raw[];
    LAS unsigned char* lds = (LAS unsigned char*)lds_raw;
    for (int u = threadIdx.x; u < (LDS_BYTES - LDSCTL_OFF) / 4; u += NWAVES * 64) ((LAS unsigned*)(lds + LDSCTL_OFF))[u] = 0u;
    __syncthreads();
    const int wave_s = __builtin_amdgcn_readfirstlane(threadIdx.x >> 6);
    (void)xcd_barrier_post((unsigned*)(p.ws + WS_CTL) + CW_BAR, (volatile LAS unsigned*)(lds + MISC_OFF) + 8);
#define GRID_BAR() do { const __attribute__((address_space(4))) Params* q_ = (const __attribute__((address_space(4))) Params*)__builtin_amdgcn_kernarg_segment_ptr(); LAUNDER_S(q_); \
        XcdBarrier b_; b_.bar = (unsigned*)(q_->ws + WS_CTL) + CW_BAR; b_.x = xb_xcc_id(); b_.st = (volatile LAS unsigned*)(lds + MISC_OFF) + 8; { int w0_ = wave_s; LAUNDER_S(w0_); unsigned l0_; asm volatile("v_mbcnt_lo_u32_b32 %0, -1, 0\n\tv_mbcnt_hi_u32_b32 %0, -1, %0" : "=v"(l0_)); b_.t0 = (w0_ == 0) && (l0_ == 0u); } xcd_barrier(b_); if (BAR_TWICE) xcd_barrier(b_); } while (0)
#ifndef BAR_TWICE
#define BAR_TWICE 0
#endif
#ifndef EN_MASK
#define EN_MASK 0x3FF
#endif
#ifndef REP_MASK
#define REP_MASK 0
#endif
#define PHREP(n) (((REP_MASK) >> (n)) & 1)
#define PHEN(n) (((EN_MASK) >> (n)) & 1)
    if (PHEN(8)) { for (int r_ = 0; r_ < 1 + PHREP(8); ++r_) { if (r_) GRID_BAR(); run_phase<8>(0, lds, wave_s, r_); } } GRID_BAR();
    for (int it = 0; it < 2 * DEPTH; ++it) {
        if (PHEN(0)) { for (int r_ = 0; r_ < 1 + PHREP(0); ++r_) { if (r_) GRID_BAR(); run_phase<0>(it, lds, wave_s, r_); } } GRID_BAR();
        if (PHEN(1)) { for (int r_ = 0; r_ < 1 + PHREP(1); ++r_) { if (r_) GRID_BAR(); run_phase<1>(it, lds, wave_s, r_); } } GRID_BAR();
        if (PHEN(2)) { for (int r_ = 0; r_ < 1 + PHREP(2); ++r_) { if (r_) GRID_BAR(); run_phase<2>(it, lds, wave_s, r_); } } GRID_BAR();
        if ((it & 1) == 0) {
            if (PHEN(3)) { for (int r_ = 0; r_ < 1 + PHREP(3); ++r_) { if (r_) GRID_BAR(); run_phase<3>(it, lds, wave_s, r_); } } GRID_BAR();
            if (PHEN(4)) { for (int r_ = 0; r_ < 1 + PHREP(4); ++r_) { if (r_) GRID_BAR(); run_phase<4>(it, lds, wave_s, r_); } } GRID_BAR();
            if (PHEN(5)) { for (int r_ = 0; r_ < 1 + PHREP(5); ++r_) { if (r_) GRID_BAR(); run_phase<5>(it, lds, wave_s, r_); } } GRID_BAR();
            if (PHEN(6)) { for (int r_ = 0; r_ < 1 + PHREP(6); ++r_) { if (r_) GRID_BAR(); run_phase<6>(it, lds, wave_s, r_); } } GRID_BAR();
            if (PHEN(7)) { for (int r_ = 0; r_ < 1 + PHREP(7); ++r_) { if (r_) GRID_BAR(); run_phase<7>(it, lds, wave_s, r_); } } GRID_BAR();
        }
    }
    if (PHEN(9)) { for (int r_ = 0; r_ < 1 + PHREP(9); ++r_) { if (r_) GRID_BAR(); run_phase<9>(0, lds, wave_s, r_); } }
#undef GRID_BAR
}

template <int PH> static void launch_phase(Params p, int it, int grid, hipStream_t stream) {
    static bool attr_set = false;
    if (!attr_set) { (void)hipFuncSetAttribute((const void*)phase_kernel<PH>, hipFuncAttributeMaxDynamicSharedMemorySize, LDS_BYTES); attr_set = true; }
    p.one_it = it; p.one_ph = PH;
    hipLaunchKernelGGL(phase_kernel<PH>, dim3(grid), dim3(NWAVES * 64), LDS_BYTES, stream, p);
}
extern "C" void kernel_launch(void* const* d_in, const int* in_sizes, int n_in, void* d_out, int out_size, void* d_ws, size_t ws_size, hipStream_t stream) {
    static int grid = 0;
    if (grid == 0) {
        if (n_in != 15 || in_sizes[0] != MTOK * DM || out_size != MTOK * DM || ws_size < WS_END) {
            fprintf(stderr, "kernel_launch: unexpected shapes (n_in %d, in0 %d, out %d, ws %zu, need %zu); nothing launched\n", n_in, n_in > 0 ? in_sizes[0] : -1, out_size, ws_size, (size_t)WS_END); grid = -1; return; }
        int dev = 0, cus = 0, per_cu = 0;
        if (hipGetDevice(&dev) != hipSuccess || hipDeviceGetAttribute(&cus, hipDeviceAttributeMultiprocessorCount, dev) != hipSuccess) { fprintf(stderr, "kernel_launch: device query failed\n"); grid = -1; return; }
        if (hipFuncSetAttribute((const void*)mega_fwd, hipFuncAttributeMaxDynamicSharedMemorySize, LDS_BYTES) != hipSuccess) { fprintf(stderr, "kernel_launch: hipFuncSetAttribute failed\n"); grid = -1; return; }
        if (hipOccupancyMaxActiveBlocksPerMultiprocessor(&per_cu, (const void*)mega_fwd, NWAVES * 64, LDS_BYTES) != hipSuccess || per_cu < 1)
            fprintf(stderr, "kernel_launch: note: occupancy query reports %d workgroups per CU\n", per_cu);
        (void)hipGetLastError();
        grid = cus;
    }
    if (grid < 0) return;
    if (hipMemsetAsync((char*)d_ws + WS_CTL, 0, CTL_ZERO_BYTES, stream) != hipSuccess) { fprintf(stderr, "kernel_launch: memset failed\n"); return; }
    Params p{};
    p.x = (const float*)d_in[0]; p.c = (const float*)d_in[1]; p.w_ada = (const float*)d_in[2]; p.b_ada = (const float*)d_in[3]; p.norm_g = (const float*)d_in[4];
    p.w_gu = (const float*)d_in[5]; p.w_d = (const float*)d_in[6]; p.w_in = (const float*)d_in[7]; p.w_o = (const float*)d_in[8]; p.diff_lam = (const float*)d_in[9];
    p.diff_subln = (const float*)d_in[10]; p.cmp_pe = (const float*)d_in[11]; p.cmp_w1 = (const float*)d_in[12]; p.cmp_w2 = (const float*)d_in[13]; p.final_g = (const float*)d_in[14];
    p.out = (float*)d_out; p.ws = (unsigned char*)d_ws;
#if MK_MULTI
    launch_phase<8>(p, 0, grid, stream);
#ifdef REPEAT_PRO
    launch_phase<8>(p, 0, grid, stream);
#endif
    for (int it = 0; it < 2 * DEPTH; ++it) {
        launch_phase<0>(p, it, grid, stream); launch_phase<1>(p, it, grid, stream); launch_phase<2>(p, it, grid, stream);
        if ((it & 1) == 0) { launch_phase<3>(p, it, grid, stream); launch_phase<4>(p, it, grid, stream); launch_phase<5>(p, it, grid, stream); launch_phase<6>(p, it, grid, stream);
#ifdef REPEAT_ATTN
            launch_phase<5>(p, it, grid, stream); launch_phase<6>(p, it, grid, stream);
#endif
 launch_phase<7>(p, it, grid, stream); }
    }
    launch_phase<9>(p, 0, grid, stream);
#else
    p.one_it = -1; p.one_ph = 0;
    hipLaunchKernelGGL(mega_fwd, dim3(grid), dim3(NWAVES * 64), LDS_BYTES, stream, p);
#endif
    const hipError_t le = hipPeekAtLastError();
    if (le != hipSuccess) fprintf(stderr, "kernel_launch: launch failed: %s\n", hipGetErrorName(le));
}
```
